# Optimizing an MI355X kernel written in HIP

```python
import jax
import jax.numpy as jnp
from jax import lax
import numpy as np

D_MODEL = 1024
BATCH = 32
SEQ = 2048
DEPTH = 2

CTX_LEN = 256
GRID_W = 64
ROPE_THETA = 10000.0
RMS_EPS = 1e-6
QBLK = 128
NEG_INF = -1e30
N_BRANCH = 3

MLA_HEADS = 8
MLA_NOPE = 64
MLA_ROPE = 32
MLA_V = 64
MLA_Q_RANK = 384
MLA_KV_RANK = 256
MLA_WIDTH = MLA_HEADS * MLA_V
MLA_SCALE = (MLA_NOPE + MLA_ROPE) ** -0.5

SWA_HEADS = 8
SWA_KV_HEADS = 2
SWA_GROUP = SWA_HEADS // SWA_KV_HEADS
SWA_HEAD_DIM = 64
SWA_WIDTH = SWA_HEADS * SWA_HEAD_DIM
SWA_KV_WIDTH = SWA_KV_HEADS * SWA_HEAD_DIM
WINDOW = 128
SWA_BAND = QBLK + 2 * WINDOW
SWA_SCALE = SWA_HEAD_DIM ** -0.5

AX_HEADS = 8
AX_KV_HEADS = 2
AX_GROUP = AX_HEADS // AX_KV_HEADS
AX_HEAD_DIM = 64
AX_WIDTH = AX_HEADS * AX_HEAD_DIM
AX_KV_WIDTH = AX_KV_HEADS * AX_HEAD_DIM
AX_SCALE = AX_HEAD_DIM ** -0.5

KV_SPLITS = (MLA_KV_RANK, MLA_ROPE, SWA_KV_WIDTH, SWA_KV_WIDTH, AX_KV_WIDTH, AX_KV_WIDTH)
Q_SPLITS = (MLA_Q_RANK, SWA_WIDTH, AX_WIDTH, MLA_WIDTH, SWA_WIDTH, AX_WIDTH, N_BRANCH * D_MODEL)
KV_COLS = sum(KV_SPLITS)
IN_WIDTH = KV_COLS + sum(Q_SPLITS)

kernel_name = 'hybrid_mla_swa_axial_parallel_dit_block'


def _split(t, sizes):
    offs = np.cumsum(sizes)[:-1].tolist()
    return jnp.split(t, offs, axis=-1)


def rmsnorm(x, w):
    xf = x.astype(jnp.float32)
    y = xf * lax.rsqrt(jnp.mean(xf * xf, axis=-1, keepdims=True) + RMS_EPS)
    return (y * w.astype(jnp.float32)).astype(x.dtype)


def rope_1d(x, pos):
    d = x.shape[-1]
    T = x.shape[1]
    freqs = ROPE_THETA ** (-jnp.arange(0, d, 2, dtype=jnp.float32) / d)
    ang = pos.astype(jnp.float32)[:, None] * freqs[None, :]
    bshape = (T,) + (1,) * (x.ndim - 3) + (d // 2,)
    cos = jnp.cos(ang).reshape(bshape)
    sin = jnp.sin(ang).reshape(bshape)
    xf = x.astype(jnp.float32)
    x1, x2 = xf[..., : d // 2], xf[..., d // 2:]
    return jnp.concatenate([x1 * cos - x2 * sin, x1 * sin + x2 * cos], axis=-1).astype(x.dtype)


def rope_axial(x, pos_row, pos_col):
    h = x.shape[-1] // 2
    return jnp.concatenate([rope_1d(x[..., :h], pos_row), rope_1d(x[..., h:], pos_col)], axis=-1)


def _rope_fn(pos):
    if pos is None:
        return lambda t: t
    return lambda t: rope_axial(t, pos[0], pos[1])


def attend(q, k, v, scale, mask=None, sink=None):
    s = jnp.einsum('bqhgd,bkhd->bhgqk', q.astype(jnp.float32), k.astype(jnp.float32)) * scale
    if mask is not None:
        s = jnp.where(mask, s, NEG_INF)
    if sink is not None:
        sk = jnp.broadcast_to(sink.astype(jnp.float32)[None, :, :, None, None], s.shape[:-1] + (1,))
        p = jax.nn.softmax(jnp.concatenate([s, sk], axis=-1), axis=-1)[..., :-1]
    else:
        p = jax.nn.softmax(s, axis=-1)
    o = jnp.einsum('bhgqk,bkhd->bqhgd', p, v.astype(jnp.float32))
    return o.astype(v.dtype)


def dense_latent_attention(q, k, v, k_ctx, v_ctx, scale):
    B, T, Hkv, G, Dk = q.shape
    nb = T // QBLK
    kk = jnp.concatenate([k_ctx, k], axis=1)
    vv = jnp.concatenate([v_ctx, v], axis=1)
    qb = jnp.moveaxis(q.reshape(B, nb, QBLK, Hkv, G, Dk), 1, 0)
    ob = lax.map(lambda qi: attend(qi, kk, vv, scale), qb)
    return jnp.moveaxis(ob, 0, 1).reshape(B, T, Hkv, G, -1)


def window_latent_attention(q, k, v, k_ctx, v_ctx, sink, scale):
    B, T, Hkv, G, Dk = q.shape
    nb = T // QBLK
    Lc = k_ctx.shape[1]
    pad = ((0, 0), (WINDOW, WINDOW), (0, 0), (0, 0))
    kp = jnp.pad(k, pad)
    vp = jnp.pad(v, pad)
    qb = jnp.moveaxis(q.reshape(B, nb, QBLK, Hkv, G, Dk), 1, 0)
    k_off = jnp.arange(SWA_BAND, dtype=jnp.int32) - WINDOW
    rel = k_off[None, :] - jnp.arange(QBLK, dtype=jnp.int32)[:, None]
    local = jnp.abs(rel) <= WINDOW
    ctx_mask = jnp.ones((QBLK, Lc), dtype=bool)

    def block(args):
        i, qi = args
        start = i * QBLK
        kb = lax.dynamic_slice_in_dim(kp, start, SWA_BAND, axis=1)
        vb = lax.dynamic_slice_in_dim(vp, start, SWA_BAND, axis=1)
        k_abs = start + k_off
        valid = (k_abs >= 0) & (k_abs < T)
        mask = jnp.concatenate([ctx_mask, local & valid[None, :]], axis=1)
        kk = jnp.concatenate([k_ctx, kb], axis=1)
        vv = jnp.concatenate([v_ctx, vb], axis=1)
        return attend(qi, kk, vv, scale, mask=mask, sink=sink)

    ob = lax.map(block, (jnp.arange(nb, dtype=jnp.int32), qb))
    return jnp.moveaxis(ob, 0, 1).reshape(B, T, Hkv, G, -1)


def project_kv(p, lw, pos):
    B, T, _ = p.shape
    rope = _rope_fn(pos)
    ckv, kr, sk, sv, ak, av = _split(p, KV_SPLITS)
    kv_m = (rmsnorm(ckv, lw['mla_kv_norm']) @ lw['mla_w_ukv']).reshape(B, T, MLA_HEADS, MLA_NOPE + MLA_V)
    k_rope = rope(kr.reshape(B, T, 1, MLA_ROPE))
    k_m = jnp.concatenate([kv_m[..., :MLA_NOPE], jnp.broadcast_to(k_rope, (B, T, MLA_HEADS, MLA_ROPE))], axis=-1)
    v_m = kv_m[..., MLA_NOPE:]
    k_s = rope(sk.reshape(B, T, SWA_KV_HEADS, SWA_HEAD_DIM))
    v_s = sv.reshape(B, T, SWA_KV_HEADS, SWA_HEAD_DIM)
    k_a = rope(rmsnorm(ak.reshape(B, T, AX_KV_HEADS, AX_HEAD_DIM), lw['ax_k_norm']))
    v_a = av.reshape(B, T, AX_KV_HEADS, AX_HEAD_DIM)
    return k_m, v_m, k_s, v_s, k_a, v_a


def project_q(p, lw, pos):
    B, T, _ = p.shape
    rope = _rope_fn(pos)
    cq, sq, aq, z_m, z_s, z_a, g = _split(p, Q_SPLITS)
    q_m = (rmsnorm(cq, lw['mla_q_norm']) @ lw['mla_w_uq']).reshape(B, T, MLA_HEADS, 1, MLA_NOPE + MLA_ROPE)
    q_m = jnp.concatenate([q_m[..., :MLA_NOPE], rope(q_m[..., MLA_NOPE:])], axis=-1)
    q_s = rope(sq.reshape(B, T, SWA_KV_HEADS, SWA_GROUP, SWA_HEAD_DIM))
    q_a = rope(rmsnorm(aq.reshape(B, T, AX_KV_HEADS, AX_GROUP, AX_HEAD_DIM), lw['ax_q_norm']))
    return q_m, q_s, q_a, z_m, z_s, z_a, g


def merge_branches(o_m, o_s, o_a, z_m, z_s, z_a, g, lw):
    B, T = o_m.shape[:2]
    y_m = (o_m.reshape(B, T, MLA_WIDTH) * jax.nn.silu(z_m)) @ lw['w_o_mla']
    y_s = (o_s.reshape(B, T, SWA_WIDTH) * jax.nn.silu(z_s)) @ lw['w_o_swa']
    y_a = (o_a.reshape(B, T, AX_WIDTH) * jax.nn.silu(z_a)) @ lw['w_o_ax']
    g_m, g_s, g_a = jnp.split(g, N_BRANCH, axis=-1)
    y = jax.nn.sigmoid(g_m) * y_m + jax.nn.sigmoid(g_s) * y_s + jax.nn.sigmoid(g_a) * y_a
    return y @ lw['w_out']


def hybrid_layer(x, ctx, c, c_ctx, lw, pos, update_ctx):
    mod_x = jax.nn.silu(c) @ lw['ada_w'] + lw['ada_b']
    mod_c = jax.nn.silu(c_ctx) @ lw['ada_w'] + lw['ada_b']
    shift, scale, gate = jnp.split(mod_x[:, None, :], 3, axis=-1)
    c_shift, c_scale, c_gate = jnp.split(mod_c, 3, axis=-1)
    h = rmsnorm(x, lw['norm_w']) * (1 + scale) + shift
    hc = rmsnorm(ctx, lw['norm_w']) * (1 + c_scale) + c_shift

    p = h @ lw['w_in']
    k_m, v_m, k_s, v_s, k_a, v_a = project_kv(p[..., :KV_COLS], lw, pos)
    q_m, q_s, q_a, z_m, z_s, z_a, g = project_q(p[..., KV_COLS:], lw, pos)
    kc_m, vc_m, kc_s, vc_s, kc_a, vc_a = project_kv(hc @ lw['w_in'][:, :KV_COLS], lw, None)

    sink = lw['swa_sink'].reshape(SWA_KV_HEADS, SWA_GROUP)
    o_m = dense_latent_attention(q_m, k_m, v_m, kc_m, vc_m, MLA_SCALE)
    o_s = window_latent_attention(q_s, k_s, v_s, kc_s, vc_s, sink, SWA_SCALE)
    o_a = dense_latent_attention(q_a, k_a, v_a, kc_a, vc_a, AX_SCALE)
    x = x + gate * merge_branches(o_m, o_s, o_a, z_m, z_s, z_a, g, lw)

    if update_ctx:
        qc_m, qc_s, qc_a, zc_m, zc_s, zc_a, gc = project_q(hc @ lw['w_in'][:, KV_COLS:], lw, None)
        oc_m = attend(qc_m, kc_m, vc_m, MLA_SCALE)
        oc_s = attend(qc_s, kc_s, vc_s, SWA_SCALE, sink=sink)
        oc_a = attend(qc_a, kc_a, vc_a, AX_SCALE)
        ctx = ctx + c_gate * merge_branches(oc_m, oc_s, oc_a, zc_m, zc_s, zc_a, gc, lw)
    return x, ctx


def setup_inputs(seed: int = 0) -> dict:
    key = jax.random.key(seed)
    ks = jax.random.split(key, 20)
    D = D_MODEL
    f32 = jnp.float32

    def nrm(k, shape, scale):
        return jax.random.normal(k, shape, f32) * scale

    return {
        'x': nrm(ks[0], (BATCH, SEQ, D), 1.0),
        'c': nrm(ks[1], (BATCH, D), 1.0),
        'ctx': nrm(ks[2], (BATCH, CTX_LEN, D), 1.0),
        'c_ctx': nrm(ks[3], (D,), 1.0),
        'ada_w': nrm(ks[4], (DEPTH, D, 3 * D), 0.5 * D ** -0.5),
        'ada_b': nrm(ks[5], (DEPTH, 3 * D), 0.02),
        'norm_w': 1.0 + nrm(ks[6], (DEPTH, D), 0.1),
        'w_in': nrm(ks[7], (DEPTH, D, IN_WIDTH), D ** -0.5),
        'mla_q_norm': 1.0 + nrm(ks[8], (DEPTH, MLA_Q_RANK), 0.1),
        'mla_w_uq': nrm(ks[9], (DEPTH, MLA_Q_RANK, MLA_HEADS * (MLA_NOPE + MLA_ROPE)), MLA_Q_RANK ** -0.5),
        'mla_kv_norm': 1.0 + nrm(ks[10], (DEPTH, MLA_KV_RANK), 0.1),
        'mla_w_ukv': nrm(ks[11], (DEPTH, MLA_KV_RANK, MLA_HEADS * (MLA_NOPE + MLA_V)), MLA_KV_RANK ** -0.5),
        'swa_sink': nrm(ks[12], (DEPTH, SWA_HEADS), 0.5),
        'ax_q_norm': 1.0 + nrm(ks[13], (DEPTH, AX_HEAD_DIM), 0.1),
        'ax_k_norm': 1.0 + nrm(ks[14], (DEPTH, AX_HEAD_DIM), 0.1),
        'w_o_mla': nrm(ks[15], (DEPTH, MLA_WIDTH, D), MLA_WIDTH ** -0.5),
        'w_o_swa': nrm(ks[16], (DEPTH, SWA_WIDTH, D), SWA_WIDTH ** -0.5),
        'w_o_ax': nrm(ks[17], (DEPTH, AX_WIDTH, D), AX_WIDTH ** -0.5),
        'w_out': nrm(ks[18], (DEPTH, D, D), D ** -0.5),
        'final_norm_w': 1.0 + nrm(ks[19], (D,), 0.1),
    }


def reference(x, c, ctx, c_ctx, ada_w, ada_b, norm_w, w_in, mla_q_norm, mla_w_uq, mla_kv_norm, mla_w_ukv,
              swa_sink, ax_q_norm, ax_k_norm, w_o_mla, w_o_swa, w_o_ax, w_out, final_norm_w):
    T = x.shape[1]
    rows = T // GRID_W
    pos_row = jnp.repeat(jnp.arange(rows, dtype=jnp.int32), GRID_W)
    pos_col = jnp.tile(jnp.arange(GRID_W, dtype=jnp.int32), rows)
    pos = (pos_row, pos_col)
    for l in range(DEPTH):
        lw = {
            'ada_w': ada_w[l], 'ada_b': ada_b[l], 'norm_w': norm_w[l], 'w_in': w_in[l],
            'mla_q_norm': mla_q_norm[l], 'mla_w_uq': mla_w_uq[l],
            'mla_kv_norm': mla_kv_norm[l], 'mla_w_ukv': mla_w_ukv[l],
            'swa_sink': swa_sink[l], 'ax_q_norm': ax_q_norm[l], 'ax_k_norm': ax_k_norm[l],
            'w_o_mla': w_o_mla[l], 'w_o_swa': w_o_swa[l], 'w_o_ax': w_o_ax[l], 'w_out': w_out[l],
        }
        x, ctx = hybrid_layer(x, ctx, c, c_ctx, lw, pos, update_ctx=(l < DEPTH - 1))
    return rmsnorm(x, final_norm_w)
```

```cpp
#include <hip/hip_runtime.h>
#include <hip/hip_cooperative_groups.h>
#include <cstdio>
#include <cstdint>
namespace cg = cooperative_groups;

#ifndef MULTI_LAUNCH
#define MULTI_LAUNCH 0
#endif

#define LAS __attribute__((address_space(3)))
typedef unsigned short bf16_t;
typedef short bf16x8 __attribute__((ext_vector_type(8)));
typedef float f32x4 __attribute__((ext_vector_type(4)));
typedef unsigned u32x2 __attribute__((ext_vector_type(2)));
typedef unsigned u32x4 __attribute__((ext_vector_type(4)));

constexpr int DM = 1024, NBATCH = 32, SEQ = 2048, CTXL = 256, SROWS = CTXL + SEQ;
constexpr int NB = 16, NCHUNK = NBATCH / NB, R = NB * SROWS;
constexpr int INW = 6816, N1 = 27 * 256;
constexpr float EPS = 1e-6f;
constexpr float LOG2E = 1.4426950408889634f;
constexpr float QS64 = 0.125f * LOG2E;
constexpr float QS96 = 0.10206207261596575f * LOG2E;
constexpr int NPHASE = 1 + NCHUNK * 13;

constexpr size_t al256(size_t x) { return (x + 255) & ~(size_t)255; }
constexpr size_t OFF_BAR  = 4096;
constexpr size_t OFF_MODX = 4096 + 16384;
constexpr size_t OFF_W1   = al256(OFF_MODX + (size_t)2 * 33 * 3072 * 4);
constexpr size_t OFF_W2A  = OFF_W1 + (size_t)2 * N1 * 1024 * 2;
constexpr size_t OFF_W2B  = OFF_W2A + (size_t)2 * 768 * 384 * 2;
constexpr size_t OFF_W3   = OFF_W2B + (size_t)2 * 1024 * 256 * 2;
constexpr size_t OFF_W4   = OFF_W3 + (size_t)2 * 3 * 1024 * 512 * 2;
constexpr size_t OFF_CTX1 = OFF_W4 + (size_t)2 * 1024 * 1024 * 2;
constexpr size_t OFF_H    = OFF_CTX1 + (size_t)8192 * 1024 * 4;
constexpr size_t OFF_CKV  = OFF_H + (size_t)R * 1024 * 2;
constexpr size_t OFF_CQ   = OFF_CKV + (size_t)R * 256 * 2;
constexpr size_t OFF_SS   = OFF_CQ + (size_t)R * 384 * 2;
constexpr size_t OFF_QM   = al256(OFF_SS + (size_t)R * 20 * 4);
constexpr size_t OFF_QS   = OFF_QM + (size_t)R * 768 * 2;
constexpr size_t OFF_QA   = OFF_QS + (size_t)R * 512 * 2;
constexpr size_t OFF_KM   = OFF_QA + (size_t)R * 512 * 2;
constexpr size_t OFF_VMT  = OFF_KM + (size_t)R * 768 * 2;
constexpr size_t OFF_KS   = OFF_VMT + (size_t)R * 512 * 2;
constexpr size_t OFF_KA   = OFF_KS + (size_t)R * 128 * 2;
constexpr size_t OFF_VST  = OFF_KA + (size_t)R * 128 * 2;
constexpr size_t OFF_VAT  = OFF_VST + (size_t)R * 128 * 2;
constexpr size_t OFF_Z    = OFF_VAT + (size_t)R * 128 * 2;
constexpr size_t OFF_G    = OFF_Z + (size_t)R * 1536 * 2;
constexpr size_t WS_END   = OFF_G + (size_t)R * 3072 * 2;

struct Params {
    const float *x, *c, *ctx, *c_ctx, *ada_w, *ada_b, *norm_w, *w_in, *mla_q_norm, *mla_w_uq, *mla_kv_norm, *mla_w_ukv,
                *swa_sink, *ax_q_norm, *ax_k_norm, *w_o_mla, *w_o_swa, *w_o_ax, *w_out, *final_norm_w;
    float* out; unsigned char* ws; int ph_lo, ph_hi;
};

typedef __bf16 bf16x2_t __attribute__((ext_vector_type(2)));
typedef float f32x2_t __attribute__((ext_vector_type(2)));
__device__ __forceinline__ unsigned pk(float lo, float hi) { const f32x2_t v = {lo, hi}; const bf16x2_t b = __builtin_convertvector(v, bf16x2_t); return __builtin_bit_cast(unsigned, b); }
__device__ __forceinline__ float bflo(unsigned w) { return __builtin_bit_cast(float, w << 16); }
__device__ __forceinline__ float bfhi(unsigned w) { return __builtin_bit_cast(float, w & 0xffff0000u); }
__device__ __forceinline__ void st4(bf16_t* p, f32x4 v) { u32x2 w; w.x = pk(v[0], v[1]); w.y = pk(v[2], v[3]); *(u32x2*)p = w; }
__device__ __forceinline__ f32x4 ld4(const bf16_t* p) { const u32x2 w = *(const u32x2*)p; return (f32x4){bflo(w.x), bfhi(w.x), bflo(w.y), bfhi(w.y)}; }
__device__ __forceinline__ void st8(bf16_t* p, f32x4 a, f32x4 b) { u32x4 w; w.x = pk(a[0], a[1]); w.y = pk(a[2], a[3]); w.z = pk(b[0], b[1]); w.w = pk(b[2], b[3]); *(u32x4*)p = w; }
__device__ __forceinline__ void ld8(const bf16_t* p, f32x4& a, f32x4& b) { const u32x4 w = *(const u32x4*)p; a = (f32x4){bflo(w.x), bfhi(w.x), bflo(w.y), bfhi(w.y)}; b = (f32x4){bflo(w.z), bfhi(w.z), bflo(w.w), bfhi(w.w)}; }
__device__ __forceinline__ int perm32(int rho) { const int n = rho >> 4, i = rho & 15; return 8 * (i >> 2) + 4 * n + (i & 3); }
__device__ __forceinline__ int permrow(int r) { return (r & ~31) + perm32(r & 31); }
__device__ __forceinline__ float ex2(float x) { return __builtin_amdgcn_exp2f(x); }
__device__ __forceinline__ float sigm(float x) { return __builtin_amdgcn_rcpf(1.0f + ex2(-x * LOG2E)); }
__device__ __forceinline__ float xsum4(float s) { s += __shfl_xor(s, 16); s += __shfl_xor(s, 32); return s; }
__device__ __forceinline__ float sq4(f32x4 v) { return (v[0] * v[0] + v[1] * v[1]) + (v[2] * v[2] + v[3] * v[3]); }
__device__ __forceinline__ float vmax3(float a, float b, float c) { float r; asm("v_max3_f32 %0, %1, %2, %3" : "=v"(r) : "v"(a), "v"(b), "v"(c)); return r; }
__device__ __forceinline__ float vmax2(float a, float b) { float r; asm("v_max_f32 %0, %1, %2" : "=v"(r) : "v"(a), "v"(b)); return r; }
__device__ __forceinline__ int vcu_of(int c, int G) { return (G == 256) ? ((c & 7) * 32 + (c >> 3)) : c; }

__device__ __forceinline__ void rot4(f32x4& x1, f32x4& x2, float pos, int idx0, float fexp) {
#pragma unroll
    for (int j = 0; j < 4; ++j) {
        const float f = ex2(-(float)(idx0 + j) * fexp), a = pos * f, cs = __cosf(a), sn = __sinf(a);
        const float a1 = x1[j], a2 = x2[j];
        x1[j] = a1 * cs - a2 * sn; x2[j] = a1 * sn + a2 * cs;
    }
}
constexpr float FEXP16 = 0.83048202372184058f;
constexpr float FEXP8  = 1.66096404744368117f;

namespace pg8 {
constexpr int BM = 256, BK = 64, HALF = 128, HTB = HALF * BK * 2, STAGE_BYTES = 8 * HTB;
__device__ __forceinline__ int lds_byte(int r, int c) { const int st = (r >> 4) * 2 + (c >> 5), rr = r & 15, cc = c & 31, ob = rr * 64 + cc * 2; return st * 1024 + (ob ^ (((ob >> 9) & 1) << 5)); }
__device__ __forceinline__ void stage_rc(int b, int& Rr, int& C) { const int st = b / 1024, sb = b % 1024, swz = sb ^ (((sb >> 9) & 1) << 5); Rr = (st >> 1) * 16 + swz / 64; C = (st & 1) * 32 + (swz % 64) / 2; }

struct Unit { const char* a; const char* b; int p0, p1, p2, p3; };
struct Gemm { int lda, ldb, K; };

template <class Epi, class Sched>
__device__ __forceinline__ void gemm_phase(LAS unsigned char* lds, const Gemm g, const Sched& S, const Epi& E, const int tid) {
    const int wid = __builtin_amdgcn_readfirstlane(tid >> 6), lane = tid & 63, wr = wid >> 2, wc = wid & 3, fr = lane & 15, fq = lane >> 4;
    const int K = g.K, nt = K / BK;
    unsigned voffA[2], voffB[2];
#pragma unroll
    for (int i = 0; i < 2; ++i) { int Rr, C; stage_rc(tid * 16 + i * 8192, Rr, C); voffA[i] = (unsigned)(Rr * g.lda + C) * 2u; voffB[i] = (unsigned)(Rr * g.ldb + C) * 2u; }
    const size_t kstep = (size_t)(BK * 2);
    const size_t hstepA = (size_t)HALF * g.lda * 2, hstepB = (size_t)HALF * g.ldb * 2;
    const unsigned ldsw = (unsigned)wid * 1024u;
    const int aoff = lds_byte(wr * 64 + fr, fq * 8), boff = lds_byte(wc * 32 + fr, fq * 8);
#define PG8_SA(b, h) (((b) * 2 + (h)) * HTB)
#define PG8_SB(b, h) ((4 + (b) * 2 + (h)) * HTB)
#define PG8_STAGE(bufoff, gbase, voff) do { _Pragma("unroll") for (int _i = 0; _i < 2; ++_i) \
        __builtin_amdgcn_global_load_lds((const unsigned*)((const char*)(gbase) + (voff)[_i]), (LAS unsigned*)(lds + (bufoff) + ldsw + _i * 8192), 16, 0, 0); } while (0)
#define PG8_LDA(dst, b, h) do { _Pragma("unroll") for (int m = 0; m < 4; ++m) _Pragma("unroll") for (int k = 0; k < 2; ++k) dst[m][k] = *(const LAS bf16x8*)(lds + PG8_SA(b, h) + aoff + m * 2048 + k * 1024); } while (0)
#define PG8_LDB(dst, b, h) do { _Pragma("unroll") for (int n = 0; n < 2; ++n) _Pragma("unroll") for (int k = 0; k < 2; ++k) dst[n][k] = *(const LAS bf16x8*)(lds + PG8_SB(b, h) + boff + n * 2048 + k * 1024); } while (0)
#define PG8_MMA(ai, bj, At, Bt) do { __builtin_amdgcn_s_setprio(1); _Pragma("unroll") for (int m = 0; m < 4; ++m) _Pragma("unroll") for (int n = 0; n < 2; ++n) _Pragma("unroll") for (int k = 0; k < 2; ++k) \
        acc[ai][bj][m][n] = __builtin_amdgcn_mfma_f32_16x16x32_bf16(Bt[n][k], At[m][k], acc[ai][bj][m][n], 0, 0, 0); __builtin_amdgcn_s_setprio(0); } while (0)
#define PG8_WAIT_V(n) asm volatile("s_waitcnt vmcnt(" #n ")" ::: "memory")
#define PG8_WAIT_L(n) asm volatile("s_waitcnt lgkmcnt(" #n ")" ::: "memory")
#define PG8_BAR __builtin_amdgcn_s_barrier()
#define PG8_SCHED __builtin_amdgcn_sched_barrier(0)
    Unit cur, nxt; int ui = 0;
    if (!S.next(0, cur)) return;
    f32x4 acc[2][2][4][2];
#pragma unroll
    for (int a = 0; a < 2; ++a)
#pragma unroll
        for (int b = 0; b < 2; ++b)
#pragma unroll
            for (int m = 0; m < 4; ++m)
#pragma unroll
                for (int n = 0; n < 2; ++n) acc[a][b][m][n] = (f32x4){0.f, 0.f, 0.f, 0.f};
    bf16x8 At[4][2], B0[2][2], B1[2][2];
    const char* cA = cur.a; const char* cB = cur.b;
    asm volatile("s_waitcnt vmcnt(0)" ::: "memory");
    PG8_STAGE(PG8_SB(0, 0), cB, voffB); PG8_STAGE(PG8_SB(0, 1), cB + hstepB, voffB); PG8_STAGE(PG8_SA(0, 0), cA, voffA); PG8_STAGE(PG8_SA(0, 1), cA + hstepA, voffA);
    if (wr == 1) PG8_BAR;
    PG8_WAIT_V(2); PG8_BAR;
    PG8_STAGE(PG8_SB(1, 0), cB + kstep, voffB); PG8_STAGE(PG8_SA(1, 0), cA + kstep, voffA); PG8_STAGE(PG8_SB(1, 1), cB + hstepB + kstep, voffB);
    PG8_WAIT_V(6); PG8_BAR;
    for (;;) {
        const bool has_next = S.next(ui + 1, nxt);
        const char* nA = has_next ? nxt.a : cA; const char* nB = has_next ? nxt.b : cB;
        for (int t = 0; t < nt; t += 2) {
            const bool last = (t == nt - 2);
            const char* a1 = cA + (size_t)(t + 1) * kstep;
            const char* a2 = last ? nA : cA + (size_t)(t + 2) * kstep; const char* b2 = last ? nB : cB + (size_t)(t + 2) * kstep;
            const char* a3 = a2 + kstep; const char* b3 = b2 + kstep;
            PG8_LDB(B0, 0, 0); PG8_LDB(B1, 0, 1); PG8_SCHED; PG8_LDA(At, 0, 0); PG8_STAGE(PG8_SA(1, 1), a1 + hstepA, voffA);
            PG8_WAIT_V(8); PG8_WAIT_L(0); PG8_BAR; PG8_MMA(0, 0, At, B0); PG8_MMA(0, 1, At, B1); PG8_BAR; PG8_SCHED;
            PG8_LDA(At, 0, 1); PG8_STAGE(PG8_SB(0, 0), b2, voffB); PG8_STAGE(PG8_SB(0, 1), b2 + hstepB, voffB); PG8_STAGE(PG8_SA(0, 0), a2, voffA);
            PG8_WAIT_V(8); PG8_WAIT_L(0); PG8_BAR; PG8_MMA(1, 0, At, B0); PG8_MMA(1, 1, At, B1); PG8_BAR; PG8_SCHED;
            PG8_LDB(B0, 1, 0); PG8_LDB(B1, 1, 1); PG8_SCHED; PG8_LDA(At, 1, 0); PG8_STAGE(PG8_SA(0, 1), a2 + hstepA, voffA);
            PG8_WAIT_V(8); PG8_WAIT_L(0); PG8_BAR; PG8_MMA(0, 0, At, B0); PG8_MMA(0, 1, At, B1); PG8_BAR; PG8_SCHED;
            PG8_LDA(At, 1, 1); PG8_STAGE(PG8_SB(1, 0), b3, voffB); PG8_STAGE(PG8_SB(1, 1), b3 + hstepB, voffB); PG8_STAGE(PG8_SA(1, 0), a3, voffA);
            PG8_WAIT_V(8); PG8_WAIT_L(0); PG8_BAR; PG8_MMA(1, 0, At, B0); PG8_MMA(1, 1, At, B1); PG8_BAR; PG8_SCHED;
        }
        if (wr == 0) PG8_BAR;
        E(acc, cur, wr, wc, fr, fq);
        if (!has_next) break;
        if (!E.keep(cur)) {
#pragma unroll
        for (int a = 0; a < 2; ++a)
#pragma unroll
            for (int b = 0; b < 2; ++b)
#pragma unroll
                for (int m = 0; m < 4; ++m)
#pragma unroll
                    for (int n = 0; n < 2; ++n) acc[a][b][m][n] = (f32x4){0.f, 0.f, 0.f, 0.f};
        }
        cur = nxt; cA = nA; cB = nB; ++ui;
        if (wr == 1) PG8_BAR;
    }
    PG8_WAIT_V(0);
    PG8_BAR;
#undef PG8_SA
#undef PG8_SB
#undef PG8_STAGE
#undef PG8_LDA
#undef PG8_LDB
#undef PG8_MMA
#undef PG8_WAIT_V
#undef PG8_WAIT_L
#undef PG8_BAR
#undef PG8_SCHED
}
}
using pg8::Unit;
typedef const f32x4 (&AccRef)[2][2][4][2];

typedef const __attribute__((address_space(4))) Params* KParams;
struct Cx {
    KParams p; int ch, l, G, vcu, tid, bid;
    __device__ __forceinline__ unsigned char* ws() const { return p->ws; }
    __device__ __forceinline__ bf16_t* bp(size_t off) const { return (bf16_t*)(p->ws + off); }
    __device__ __forceinline__ float* fp(size_t off) const { return (float*)(p->ws + off); }
};

struct SchedP2 {
    Cx c; int total;
    __device__ __forceinline__ SchedP2(const Cx& c_) : c(c_) { total = 128 * 27 + 16 * (c_.l == 0 ? 27 : 4); }
    __device__ __forceinline__ bool next(int i, Unit& u) const {
        const int L = i * c.G + c.vcu; if (L >= total) return false;
        int lt, ct, isctx = 0, rt;
        if (L < 3456) { const int g = L / 24, w = L % 24; lt = (g & 15) * 8 + (w & 7); ct = (g >> 4) * 3 + (w >> 3); rt = (lt >> 3) * 9 + 1 + (lt & 7); }
        else { const int Lc = L - 3456; const int q = Lc >> 4; rt = (Lc & 15) * 9; isctx = 1; ct = (c.l == 0) ? q : (q == 0 ? 0 : q + 1); }
        const char* hrow = (const char*)(c.ws() + OFF_H) + (size_t)rt * 256 * 1024 * 2;
        const char* wrow = (const char*)(c.ws() + OFF_W1) + ((size_t)c.l * N1 + (size_t)ct * 256) * 1024 * 2;
        if (ct == 4) { u.a = wrow; u.b = hrow; } else { u.a = hrow; u.b = wrow; }
        u.p0 = rt * 256; u.p1 = ct; u.p2 = isctx; u.p3 = 0; return true;
    }
};
struct EpiP2 {
    Cx c;
    __device__ __forceinline__ bool keep(const Unit&) const { return false; }
    __device__ __forceinline__ void operator()(AccRef acc, const Unit& u, int wr, int wc, int fr, int fq) const {
        const int row0 = u.p0, ct = u.p1; const bool isctx = u.p2 != 0; const int l = c.l;
        const int bl = row0 / SROWS, rr0 = row0 - bl * SROWS;
        if (ct <= 2) {
            bf16_t* ckv = c.bp(OFF_CKV); bf16_t* cq = c.bp(OFF_CQ); float* ss = c.fp(OFF_SS); bf16_t* km = c.bp(OFF_KM);
#pragma unroll
            for (int ai = 0; ai < 2; ++ai)
#pragma unroll
                for (int m = 0; m < 4; ++m) {
                    const int rl = ai * 128 + wr * 64 + m * 16 + fr; const size_t row = (size_t)(row0 + rl);
#pragma unroll
                    for (int bj = 0; bj < 2; ++bj) {
                        f32x4 v0 = acc[ai][bj][m][0], v1 = acc[ai][bj][m][1];
                        const int col = bj * 128 + wc * 32 + 4 * fq;
                        if (ct == 2 && bj == 1) {
                            if (wc == 0) {
                                if (!isctx) { const int t = rr0 + rl - CTXL; const float pos = (fq >> 1) ? (float)(t & 63) : (float)(t >> 6); rot4(v0, v1, pos, (4 * fq) & 7, FEXP8); }
#pragma unroll
                                for (int h = 0; h < 8; ++h) { st4(km + row * 768 + h * 96 + 64 + 4 * fq, v0); st4(km + row * 768 + h * 96 + 80 + 4 * fq, v1); }
                            }
                        } else {
                            const float s = xsum4(sq4(v0) + sq4(v1));
                            const int colp = bj * 128 + wc * 32 + 8 * fq;
                            if (ct == 0) { st8(ckv + row * 256 + colp, v0, v1); if (fq == 0) ss[row * 20 + bj * 4 + wc] = s; }
                            else if (ct == 1) { st8(cq + row * 384 + colp, v0, v1); if (fq == 0) ss[row * 20 + 8 + bj * 4 + wc] = s; }
                            else { st8(cq + row * 384 + 256 + colp, v0, v1); if (fq == 0) ss[row * 20 + 16 + wc] = s; }
                        }
                    }
                    asm volatile("" ::: "memory");
                }
        } else if (ct == 3 || (ct >= 5 && ct <= 8)) {
            bf16_t* dst; int ld, hcol; bool nrm; const float* nw = nullptr; float qs = 1.0f;
            if (ct == 3) { nrm = (wc >> 1) != 0; dst = c.bp(nrm ? OFF_KA : OFF_KS); ld = 128; hcol = (wc & 1) * 64; nw = c.p->ax_k_norm + l * 64; }
            else if (ct <= 6) { nrm = false; dst = c.bp(OFF_QS); ld = 512; hcol = ((ct - 5) * 4 + wc) * 64; qs = QS64; }
            else { nrm = true; dst = c.bp(OFF_QA); ld = 512; hcol = ((ct - 7) * 4 + wc) * 64; qs = QS64; nw = c.p->ax_q_norm + l * 64; }
            f32x4 w4[2][2];
#pragma unroll
            for (int bj = 0; bj < 2; ++bj)
#pragma unroll
                for (int n = 0; n < 2; ++n) w4[bj][n] = nrm ? *(const f32x4*)(nw + bj * 32 + n * 16 + 4 * fq) : (f32x4){1.f, 1.f, 1.f, 1.f};
#pragma unroll
            for (int ai = 0; ai < 2; ++ai)
#pragma unroll
                for (int m = 0; m < 4; ++m) {
                    const int rl = ai * 128 + wr * 64 + m * 16 + fr; const size_t row = (size_t)(row0 + rl);
                    f32x4 v[2][2];
#pragma unroll
                    for (int bj = 0; bj < 2; ++bj) { v[bj][0] = acc[ai][bj][m][0]; v[bj][1] = acc[ai][bj][m][1]; }
                    if (nrm) {
                        const float s = xsum4((sq4(v[0][0]) + sq4(v[0][1])) + (sq4(v[1][0]) + sq4(v[1][1])));
                        const float rn = __builtin_amdgcn_rsqf(s * (1.0f / 64.0f) + EPS);
#pragma unroll
                        for (int bj = 0; bj < 2; ++bj)
#pragma unroll
                            for (int n = 0; n < 2; ++n) v[bj][n] = v[bj][n] * rn * w4[bj][n];
                    }
                    if (!isctx) {
                        const int t = rr0 + rl - CTXL;
                        rot4(v[0][0], v[0][1], (float)(t >> 6), 4 * fq, FEXP16);
                        rot4(v[1][0], v[1][1], (float)(t & 63), 4 * fq, FEXP16);
                    }
#pragma unroll
                    for (int bj = 0; bj < 2; ++bj)
#pragma unroll
                        for (int n = 0; n < 2; ++n) st4(dst + row * ld + hcol + bj * 32 + n * 16 + 4 * fq, v[bj][n] * qs);
                    asm volatile("" ::: "memory");
                }
        } else if (ct == 4) {
#pragma unroll
            for (int ai = 0; ai < 2; ++ai) {
                bf16_t* vt = c.bp(ai ? OFF_VAT : OFF_VST) + ((size_t)(bl * 2 + wr) * 64) * SROWS + rr0;
#pragma unroll
                for (int m = 0; m < 4; ++m) {
                    const int d = m * 16 + fr;
#pragma unroll
                    for (int bj = 0; bj < 2; ++bj)
#pragma unroll
                        for (int n = 0; n < 2; ++n) st4(vt + (size_t)d * SROWS + bj * 128 + wc * 32 + n * 16 + 4 * fq, acc[ai][bj][m][n]);
                }
            }
        } else {
            const bool isz = ct < 15; bf16_t* dst = c.bp(isz ? OFF_Z : OFF_G); const int ld = isz ? 1536 : 3072; const int cb = (isz ? (ct - 9) : (ct - 15)) * 256;
            const float zsel = isz ? 1.0f : 0.f, gsel = isz ? 0.f : 1.0f;
#pragma unroll
            for (int ai = 0; ai < 2; ++ai)
#pragma unroll
                for (int m = 0; m < 4; ++m) {
                    const size_t row = (size_t)(row0 + ai * 128 + wr * 64 + m * 16 + fr);
#pragma unroll
                    for (int bj = 0; bj < 2; ++bj) {
                        f32x4 v0 = acc[ai][bj][m][0], v1 = acc[ai][bj][m][1];
#pragma unroll
                        for (int j = 0; j < 4; ++j) { v0[j] = __builtin_amdgcn_rcpf(1.0f + ex2(v0[j])) * (zsel * v0[j] + gsel); v1[j] = __builtin_amdgcn_rcpf(1.0f + ex2(v1[j])) * (zsel * v1[j] + gsel); }
                        st8(dst + row * ld + cb + bj * 128 + wc * 32 + 8 * fq, v0, v1);
                    }
                    asm volatile("" ::: "memory");
                }
        }
    }
};

struct SchedP3 {
    Cx c; int which, total, nrt;
    __device__ __forceinline__ SchedP3(const Cx& c_, int w) : c(c_), which(w) { nrt = (w == 1) ? 144 : (c_.l == 0 ? 144 : 128); total = nrt * (w ? 4 : 3); }
    __device__ __forceinline__ bool next(int i, Unit& u) const {
        const int L = i * c.G + c.vcu; if (L >= total) return false;
        const int nct = which ? 4 : 3; const int ri = L / nct, ct = L - ri * nct;
        int rt, isctx = 0;
        if (ri < 128) rt = (ri >> 3) * 9 + 1 + (ri & 7); else { rt = (ri - 128) * 9; isctx = 1; }
        if (which == 0) {
            u.a = (const char*)(c.ws() + OFF_CQ) + (size_t)rt * 256 * 384 * 2;
            u.b = (const char*)(c.ws() + OFF_W2A) + ((size_t)c.l * 768 + (size_t)ct * 256) * 384 * 2;
        } else {
            const char* arow = (const char*)(c.ws() + OFF_CKV) + (size_t)rt * 256 * 256 * 2;
            const char* wrow = (const char*)(c.ws() + OFF_W2B) + ((size_t)c.l * 1024 + (size_t)ct * 256) * 256 * 2;
            if (ct >= 2) { u.a = wrow; u.b = arow; } else { u.a = arow; u.b = wrow; }
        }
        u.p0 = rt * 256; u.p1 = ct; u.p2 = isctx; u.p3 = 0; return true;
    }
};
struct EpiP3 {
    Cx c; int which;
    __device__ __forceinline__ bool keep(const Unit&) const { return false; }
    __device__ __forceinline__ void operator()(AccRef acc, const Unit& u, int wr, int wc, int fr, int fq) const {
        const int row0 = u.p0, ct = u.p1; const bool isctx = u.p2 != 0;
        const int bl = row0 / SROWS, rr0 = row0 - bl * SROWS;
        const float* ss = c.fp(OFF_SS);
        if (which == 0) {
            bf16_t* qm = c.bp(OFF_QM);
#pragma unroll
            for (int ai = 0; ai < 2; ++ai) {
              float rsv[4];
#pragma unroll
              for (int m = 0; m < 4; ++m) {
                    const size_t row = (size_t)(row0 + ai * 128 + wr * 64 + m * 16 + fr);
                    const f32x4 s0 = *(const f32x4*)(ss + row * 20 + 8), s1 = *(const f32x4*)(ss + row * 20 + 12), s2 = *(const f32x4*)(ss + row * 20 + 16);
                    const float sum = ((s0[0] + s0[1]) + (s0[2] + s0[3])) + ((s1[0] + s1[1]) + (s1[2] + s1[3])) + ((s2[0] + s2[1]) + (s2[2] + s2[3]));
                    rsv[m] = __builtin_amdgcn_rsqf(sum * (1.0f / 384.0f) + EPS) * QS96;
              }
              asm volatile("" ::: "memory");
#pragma unroll
                for (int m = 0; m < 4; ++m) {
                    const int rl = ai * 128 + wr * 64 + m * 16 + fr; const size_t row = (size_t)(row0 + rl);
                    const float rs = rsv[m];
#pragma unroll
                    for (int bj = 0; bj < 2; ++bj) {
                        f32x4 v0 = acc[ai][bj][m][0] * rs, v1 = acc[ai][bj][m][1] * rs;
                        if (ct < 2) {
                            const int head = ct * 4 + bj * 2 + (wc >> 1), d = (wc & 1) * 32 + 4 * fq;
                            st4(qm + row * 768 + head * 96 + d, v0); st4(qm + row * 768 + head * 96 + d + 16, v1);
                        } else {
                            const int head = bj * 4 + wc;
                            if (!isctx) { const int t = rr0 + rl - CTXL; const float pos = (fq >> 1) ? (float)(t & 63) : (float)(t >> 6); rot4(v0, v1, pos, (4 * fq) & 7, FEXP8); }
                            st4(qm + row * 768 + head * 96 + 64 + 4 * fq, v0); st4(qm + row * 768 + head * 96 + 80 + 4 * fq, v1);
                        }
                    }
                }
              asm volatile("" ::: "memory");
            }
        } else if (ct < 2) {
            bf16_t* km = c.bp(OFF_KM);
#pragma unroll
            for (int ai = 0; ai < 2; ++ai) {
              float rsv[4];
#pragma unroll
              for (int m = 0; m < 4; ++m) {
                    const size_t row = (size_t)(row0 + ai * 128 + wr * 64 + m * 16 + fr);
                    const f32x4 s0 = *(const f32x4*)(ss + row * 20), s1 = *(const f32x4*)(ss + row * 20 + 4);
                    const float sum = ((s0[0] + s0[1]) + (s0[2] + s0[3])) + ((s1[0] + s1[1]) + (s1[2] + s1[3]));
                    rsv[m] = __builtin_amdgcn_rsqf(sum * (1.0f / 256.0f) + EPS);
              }
              asm volatile("" ::: "memory");
#pragma unroll
                for (int m = 0; m < 4; ++m) {
                    const int rl = ai * 128 + wr * 64 + m * 16 + fr; const size_t row = (size_t)(row0 + rl);
                    const float rs = rsv[m];
#pragma unroll
                    for (int bj = 0; bj < 2; ++bj) {
                        const int head = ct * 4 + bj * 2 + (wc >> 1), d = (wc & 1) * 32 + 4 * fq;
                        st4(km + row * 768 + head * 96 + d, acc[ai][bj][m][0] * rs); st4(km + row * 768 + head * 96 + d + 16, acc[ai][bj][m][1] * rs);
                    }
                }
              asm volatile("" ::: "memory");
            }
        } else {
#pragma unroll
            for (int bj = 0; bj < 2; ++bj)
#pragma unroll
                for (int n = 0; n < 2; ++n) {
                    const int tl = bj * 128 + wc * 32 + n * 16 + 4 * fq;
                    f32x4 rs;
#pragma unroll
                    for (int j = 0; j < 4; ++j) {
                        const size_t row = (size_t)(row0 + tl + j);
                        const f32x4 s0 = *(const f32x4*)(ss + row * 20), s1 = *(const f32x4*)(ss + row * 20 + 4);
                        const float sum = ((s0[0] + s0[1]) + (s0[2] + s0[3])) + ((s1[0] + s1[1]) + (s1[2] + s1[3]));
                        rs[j] = __builtin_amdgcn_rsqf(sum * (1.0f / 256.0f) + EPS);
                    }
#pragma unroll
                    for (int ai = 0; ai < 2; ++ai) {
                        bf16_t* vt = c.bp(OFF_VMT) + ((size_t)(bl * 8 + (ct - 2) * 4 + ai * 2 + wr) * 64) * SROWS + rr0 + tl;
#pragma unroll
                        for (int m = 0; m < 4; ++m) st4(vt + (size_t)(m * 16 + fr) * SROWS, acc[ai][bj][m][n] * rs);
                    }
                    asm volatile("" ::: "memory");
                }
        }
    }
};

struct SchedP5 {
    Cx c; int ntile;
    __device__ __forceinline__ SchedP5(const Cx& c_) : c(c_) { ntile = (c_.l == 0 ? 144 : 128) * 4; }
    __device__ __forceinline__ bool next(int i, Unit& u) const {
        const int it = i / 3, br = i - it * 3;
        const int L = it * c.G + c.vcu; if (L >= ntile) return false;
        const int ri = L >> 2, ct = L & 3; int rt;
        if (ri < 128) rt = (ri >> 3) * 9 + 1 + (ri & 7); else rt = (ri - 128) * 9;
        u.a = (const char*)(c.ws() + OFF_Z) + ((size_t)rt * 256 * 1536 + (size_t)br * 512) * 2;
        u.b = (const char*)(c.ws() + OFF_W3) + (((size_t)c.l * 3 + br) * 1024 + (size_t)ct * 256) * 512 * 2;
        u.p0 = rt * 256; u.p1 = ct; u.p2 = br; u.p3 = 0; return true;
    }
};
typedef f32x4 (&AccRefM)[2][2][4][2];
struct EpiP5 {
    Cx c;
    __device__ __forceinline__ bool keep(const Unit& u) const { return u.p2 < 2; }
    __device__ __forceinline__ void operator()(AccRefM acc, const Unit& u, int wr, int wc, int fr, int fq) const {
        const int row0 = u.p0, ct = u.p1, br = u.p2;
        bf16_t* y = c.bp(OFF_H); const bf16_t* g = c.bp(OFF_G);
#pragma unroll
        for (int ai = 0; ai < 2; ++ai) {
            u32x4 gw[4][2], hw[4][2];
#pragma unroll
            for (int m = 0; m < 4; ++m)
#pragma unroll
                for (int bj = 0; bj < 2; ++bj) {
                    const size_t row = (size_t)(row0 + ai * 128 + wr * 64 + m * 16 + fr); const int col = ct * 256 + bj * 128 + wc * 32 + 8 * fq;
                    gw[m][bj] = *(const u32x4*)(g + row * 3072 + br * 1024 + col);
                    if (br < 2) hw[m][bj] = *(const u32x4*)(g + row * 3072 + (br + 1) * 1024 + col);
                }
#pragma unroll
            for (int m = 0; m < 4; ++m)
#pragma unroll
                for (int bj = 0; bj < 2; ++bj) {
                    const u32x4 w = gw[m][bj];
                    f32x4 s0 = (f32x4){bflo(w.x), bfhi(w.x), bflo(w.y), bfhi(w.y)}, s1 = (f32x4){bflo(w.z), bfhi(w.z), bflo(w.w), bfhi(w.w)};
                    if (br < 2) {
                        const u32x4 v = hw[m][bj];
                        const f32x4 d0 = (f32x4){bflo(v.x), bfhi(v.x), bflo(v.y), bfhi(v.y)}, d1 = (f32x4){bflo(v.z), bfhi(v.z), bflo(v.w), bfhi(v.w)};
#pragma unroll
                        for (int j = 0; j < 4; ++j) { s0[j] *= __builtin_amdgcn_rcpf(fmaxf(d0[j], 1e-20f)); s1[j] *= __builtin_amdgcn_rcpf(fmaxf(d1[j], 1e-20f)); }
                        acc[ai][bj][m][0] = acc[ai][bj][m][0] * s0; acc[ai][bj][m][1] = acc[ai][bj][m][1] * s1;
                    } else {
                        const size_t row = (size_t)(row0 + ai * 128 + wr * 64 + m * 16 + fr); const int col = ct * 256 + bj * 128 + wc * 32 + 8 * fq;
                        st8(y + row * 1024 + col, acc[ai][bj][m][0] * s0, acc[ai][bj][m][1] * s1);
                    }
                }
            asm volatile("" ::: "memory");
        }
    }
};

struct SchedP6 {
    Cx c; int ntile;
    __device__ __forceinline__ SchedP6(const Cx& c_) : c(c_) { ntile = (c_.l == 0 ? 144 : 128) * 4; }
    __device__ __forceinline__ bool next(int i, Unit& u) const {
        const int L = i * c.G + c.vcu; if (L >= ntile) return false;
        const int ri = L >> 2, ct = L & 3; int rt, isctx = 0, grow;
        if (ri < 128) { rt = (ri >> 3) * 9 + 1 + (ri & 7); grow = (c.ch * NB + (ri >> 3)) * SEQ + (ri & 7) * 256; }
        else { rt = (ri - 128) * 9; isctx = 1; grow = (c.ch * NB + (ri - 128)) * CTXL; }
        u.a = (const char*)(c.ws() + OFF_H) + (size_t)rt * 256 * 1024 * 2;
        u.b = (const char*)(c.ws() + OFF_W4) + ((size_t)c.l * 1024 + (size_t)ct * 256) * 1024 * 2;
        u.p0 = rt * 256; u.p1 = ct; u.p2 = isctx; u.p3 = grow; return true;
    }
};
struct EpiP6 {
    Cx c;
    __device__ __forceinline__ bool keep(const Unit&) const { return false; }
    __device__ __forceinline__ void operator()(AccRef acc, const Unit& u, int wr, int wc, int fr, int fq) const {
        const int ct = u.p1; const bool isctx = u.p2 != 0; const int grow = u.p3;
        const float* src; float* dst; const float* gate;
        if (isctx) { src = c.p->ctx; dst = c.fp(OFF_CTX1); gate = c.fp(OFF_MODX) + ((size_t)c.l * 33 + 32) * 3072 + 2048; }
        else { src = (c.l == 0) ? c.p->x : c.p->out; dst = c.p->out; gate = c.fp(OFF_MODX) + ((size_t)c.l * 33 + (grow >> 11)) * 3072 + 2048; }
#pragma unroll
        for (int bj = 0; bj < 2; ++bj) {
            const int col = ct * 256 + bj * 128 + wc * 32 + 8 * fq;
            const f32x4 gt0 = *(const f32x4*)(gate + col), gt1 = *(const f32x4*)(gate + col + 4);
#pragma unroll
            for (int ai = 0; ai < 2; ++ai) {
                f32x4 xo[4][2];
#pragma unroll
                for (int m = 0; m < 4; ++m) {
                    const size_t row = (size_t)(grow + ai * 128 + wr * 64 + m * 16 + fr);
                    xo[m][0] = *(const f32x4*)(src + row * 1024 + col); xo[m][1] = *(const f32x4*)(src + row * 1024 + col + 4);
                }
#pragma unroll
                for (int m = 0; m < 4; ++m) {
                    const size_t row = (size_t)(grow + ai * 128 + wr * 64 + m * 16 + fr);
                    *(f32x4*)(dst + row * 1024 + col) = xo[m][0] + gt0 * acc[ai][bj][m][0];
                    *(f32x4*)(dst + row * 1024 + col + 4) = xo[m][1] + gt1 * acc[ai][bj][m][1];
                }
                asm volatile("" ::: "memory");
            }
        }
    }
};

constexpr int A_PV = 144, A_KB = 13312, A_STG = A_KB + 64 * A_PV;
template <int DK>
__device__ __forceinline__ void attn_unit(LAS unsigned char* lds, const bf16_t* __restrict__ Qp, int ldq, const bf16_t* __restrict__ Kp, int ldk,
                                          const bf16_t* __restrict__ VTp, bf16_t* Zp, int q0, int nq, int kb0, int kb1, bool swa, float m_init, float l_init_, const int tid, const bool grp = false, const float* sinkp = nullptr) {
    constexpr int KS = DK / 32, PK = DK * 2 + 16, KCH = DK / 8;
    const int wave = __builtin_amdgcn_readfirstlane(tid >> 6), lane = tid & 63, fr = lane & 15, fq = lane >> 4;
    const bool active = grp ? true : (wave * 64 < nq);
    const int qw = q0 + (grp ? (wave & 1) * 64 : wave * 64);
    if (grp) { Qp += (wave >> 1) * 64; Zp += (wave >> 1) * 64; }
    const float l_init = grp ? ex2(sinkp[wave >> 1] * LOG2E) : l_init_;
    constexpr int KSR = (DK == 96) ? 2 : KS;
    constexpr int QL_OFF = 2 * A_STG, QL_PITCH = 80;
    bf16x8 qf[4][KSR];
#pragma unroll
    for (int n = 0; n < 4; ++n)
#pragma unroll
        for (int ks = 0; ks < KSR; ++ks) qf[n][ks] = active ? *(const bf16x8*)(Qp + (size_t)(qw + n * 16 + fr) * ldq + ks * 32 + fq * 8) : (bf16x8){0, 0, 0, 0, 0, 0, 0, 0};
    LAS unsigned char* qlds = lds + QL_OFF + wave * (64 * QL_PITCH);
    if (DK == 96) {
#pragma unroll
        for (int n = 0; n < 4; ++n) {
            const bf16x8 t = active ? *(const bf16x8*)(Qp + (size_t)(qw + n * 16 + fr) * ldq + 64 + fq * 8) : (bf16x8){0, 0, 0, 0, 0, 0, 0, 0};
            *(LAS bf16x8*)(qlds + (n * 16 + fr) * QL_PITCH + fq * 16) = t;
        }
    }
    f32x4 O[4][4];
#pragma unroll
    for (int a = 0; a < 4; ++a)
#pragma unroll
        for (int b = 0; b < 4; ++b) O[a][b] = (f32x4){0.f, 0.f, 0.f, 0.f};
    constexpr bool LMF = true;
    float mrun[4], lrun[4]; f32x4 L5[4]; f32x4 negm[4];
    const bf16x8 ones = (bf16x8){0x3F80, 0x3F80, 0x3F80, 0x3F80, 0x3F80, 0x3F80, 0x3F80, 0x3F80};
#pragma unroll
    for (int n = 0; n < 4; ++n) { negm[n] = (f32x4){0.f, 0.f, 0.f, 0.f}; mrun[n] = 0.f; lrun[n] = (fq == 0) ? l_init : 0.f; L5[n] = (f32x4){l_init, l_init, l_init, l_init}; }
    const int nT = 4 + (kb1 - kb0);
    const int kr0 = tid / KCH, kc0 = tid - kr0 * KCH;
    const int t2 = tid + 512; const int kr1 = t2 / KCH, kc1 = t2 - kr1 * KCH;
    const bool k2 = (DK == 96) && (tid < 256);
    const int vr = tid >> 3, vc = tid & 7;
    bf16x8 kreg0, kreg1 = (bf16x8){0, 0, 0, 0, 0, 0, 0, 0}, vreg;
#define A_LOAD(i) do { const int _r0 = (((i) < 4) ? (i) : kb0 + ((i) - 4)) * 64; \
        kreg0 = *(const bf16x8*)(Kp + (size_t)(_r0 + kr0) * ldk + kc0 * 8); \
        if (k2) kreg1 = *(const bf16x8*)(Kp + (size_t)(_r0 + kr1) * ldk + kc1 * 8); \
        vreg = *(const bf16x8*)(VTp + (size_t)vr * SROWS + _r0 + vc * 8); } while (0)
#define A_STORE(buf) do { LAS unsigned char* _b = lds + (buf) * A_STG; \
        *(LAS bf16x8*)(_b + kr0 * PK + kc0 * 16) = kreg0; \
        if (k2) *(LAS bf16x8*)(_b + kr1 * PK + kc1 * 16) = kreg1; \
        *(LAS bf16x8*)(_b + A_KB + vr * A_PV + vc * 16) = vreg; } while (0)
    A_LOAD(0); A_STORE(0);
    __syncthreads();
    for (int i = 0; i < nT; ++i) {
        if (i + 1 < nT) A_LOAD(i + 1);
        const int kt = (i < 4) ? i : kb0 + (i - 4);
        const bool lat = i >= 4;
        const int kl = (kt - 4) * 64, tqw = qw - CTXL;
        bool doit = active;
        if (swa && lat) { if (kl + 63 < tqw - 128 || kl > tqw + 191) doit = false; }
        if (doit) {
            const LAS unsigned char* kbuf = lds + (i & 1) * A_STG; const LAS unsigned char* vbuf = kbuf + A_KB;
#pragma unroll 1
            for (int half = 0; half < 2; ++half) {
                f32x4 S[2][4];
#pragma unroll
                for (int m = 0; m < 2; ++m)
#pragma unroll
                    for (int n = 0; n < 4; ++n) { S[m][n] = negm[n]; }
                const LAS unsigned char* kb = kbuf + (half * 32 + fr) * PK + fq * 16;
#pragma unroll
                for (int ks = 0; ks < KS; ++ks) {
                    const bf16x8 k0 = *(const LAS bf16x8*)(kb + ks * 64);
                    const bf16x8 k1 = *(const LAS bf16x8*)(kb + 16 * PK + ks * 64);
#pragma unroll
                    for (int n = 0; n < 4; ++n) {
                        bf16x8 qv;
                        if (ks < KSR) qv = qf[n][ks < KSR ? ks : 0]; else qv = *(const LAS bf16x8*)(qlds + (n * 16 + fr) * QL_PITCH + fq * 16);
                        S[0][n] = __builtin_amdgcn_mfma_f32_16x16x32_bf16(k0, qv, S[0][n], 0, 0, 0);
                        S[1][n] = __builtin_amdgcn_mfma_f32_16x16x32_bf16(k1, qv, S[1][n], 0, 0, 0);
                    }
                }
                if (swa && lat) {
#pragma unroll
                    for (int m = 0; m < 2; ++m)
#pragma unroll
                        for (int n = 0; n < 4; ++n)
#pragma unroll
                            for (int j = 0; j < 4; ++j) {
                                const int df = (tqw + n * 16 + fr) - (kl + half * 32 + m * 16 + 4 * fq + j);
                                if (df > 128 || df < -128) S[m][n][j] = -1e30f;
                            }
                }
                constexpr bool PREFV = (DK == 64);
                bf16x8 vfp[2];
                if (PREFV) {
#pragma unroll
                    for (int dt = 0; dt < 2; ++dt) {
                        const LAS unsigned char* vp = vbuf + (dt * 16 + fr) * A_PV + (half * 32 + 4 * fq) * 2;
                        const u32x2 lo = *(const LAS u32x2*)vp, hi = *(const LAS u32x2*)(vp + 32);
                        vfp[dt] = __builtin_bit_cast(bf16x8, (u32x4){lo.x, lo.y, hi.x, hi.y});
                    }
                    __builtin_amdgcn_sched_barrier(0);
                }
                asm volatile("s_nop 7\n\ts_nop 3" : "+v"(S[0][0]), "+v"(S[0][1]), "+v"(S[0][2]), "+v"(S[0][3]), "+v"(S[1][0]), "+v"(S[1][1]), "+v"(S[1][2]), "+v"(S[1][3]));
                float lm[4];
#pragma unroll
                for (int n = 0; n < 4; ++n) {
                    if (true) lm[n] = vmax2(vmax3(S[0][n][0], S[0][n][1], S[0][n][2]), vmax3(S[0][n][3], S[1][n][0], vmax3(S[1][n][1], S[1][n][2], S[1][n][3])));
                    else lm[n] = fmaxf(fmaxf(fmaxf(S[0][n][0], S[0][n][1]), fmaxf(S[0][n][2], S[0][n][3])), fmaxf(fmaxf(S[1][n][0], S[1][n][1]), fmaxf(S[1][n][2], S[1][n][3])));
                }
                const bool first = (i == 0) && (half == 0);
                if (first || __builtin_amdgcn_ballot_w64((true ? vmax2(vmax3(lm[0], lm[1], lm[2]), lm[3]) : fmaxf(fmaxf(lm[0], lm[1]), fmaxf(lm[2], lm[3]))) > 8.0f) != 0ull) {
#pragma unroll
                    for (int n = 0; n < 4; ++n) {
                        float mx = lm[n]; mx = fmaxf(mx, __shfl_xor(mx, 16)); mx = fmaxf(mx, __shfl_xor(mx, 32));
                        const float d = first ? mx : fmaxf(mx, 0.f), alpha = ex2(-d);
                        mrun[n] += d; negm[n] = negm[n] - d; if (LMF) L5[n] = L5[n] * alpha; else lrun[n] *= alpha;
#pragma unroll
                        for (int dt = 0; dt < 4; ++dt) O[dt][n] = O[dt][n] * alpha;
                        S[0][n] = S[0][n] - d; S[1][n] = S[1][n] - d;
                    }
                }
                bf16x8 pf[4];
#pragma unroll
                for (int n = 0; n < 4; ++n) {
                    f32x4 p0, p1;
#pragma unroll
                    for (int j = 0; j < 4; ++j) { p0[j] = ex2(S[0][n][j]); p1[j] = ex2(S[1][n][j]); }
                    if (!LMF) lrun[n] += (((p0[0] + p0[1]) + (p0[2] + p0[3])) + ((p1[0] + p1[1]) + (p1[2] + p1[3])));
                    u32x4 w; w.x = pk(p0[0], p0[1]); w.y = pk(p0[2], p0[3]); w.z = pk(p1[0], p1[1]); w.w = pk(p1[2], p1[3]);
                    pf[n] = __builtin_bit_cast(bf16x8, w);
                }
#pragma unroll
                for (int n = 0; n < 4; ++n) if (LMF) L5[n] = __builtin_amdgcn_mfma_f32_16x16x32_bf16(ones, pf[n], L5[n], 0, 0, 0);
#pragma unroll
                for (int dt = 0; dt < 4; ++dt) {
                    const LAS unsigned char* vp = vbuf + (dt * 16 + fr) * A_PV + (half * 32 + 4 * fq) * 2;
                    bf16x8 vf;
                    if (PREFV && dt < 2) vf = vfp[dt];
                    else { const u32x2 lo = *(const LAS u32x2*)vp, hi = *(const LAS u32x2*)(vp + 32); vf = __builtin_bit_cast(bf16x8, (u32x4){lo.x, lo.y, hi.x, hi.y}); }
#pragma unroll
                    for (int n = 0; n < 4; ++n) O[dt][n] = __builtin_amdgcn_mfma_f32_16x16x32_bf16(vf, pf[n], O[dt][n], 0, 0, 0);
                }
            }
        }
        if (i + 1 < nT) A_STORE((i + 1) & 1);
        __syncthreads();
    }
#undef A_LOAD
#undef A_STORE
    if (active) {
        u32x2 zw[4][4];
#pragma unroll
        for (int n = 0; n < 4; ++n)
#pragma unroll
            for (int dt = 0; dt < 4; ++dt) zw[n][dt] = *(const u32x2*)(Zp + (size_t)(qw + n * 16 + fr) * 1536 + 4 * fq + dt * 16);
        asm volatile("" ::: "memory");
#pragma unroll
        for (int n = 0; n < 4; ++n) {
            const float inv = __builtin_amdgcn_rcpf(LMF ? L5[n][0] : xsum4(lrun[n]));
            bf16_t* zr = Zp + (size_t)(qw + n * 16 + fr) * 1536 + 4 * fq;
#pragma unroll
            for (int dt = 0; dt < 4; ++dt) { const u32x2 w = zw[n][dt]; const f32x4 z = (f32x4){bflo(w.x), bfhi(w.x), bflo(w.y), bfhi(w.y)}; st4(zr + dt * 16, O[dt][n] * inv * z); }
        }
    }
}

__device__ __forceinline__ void attn_phase(LAS unsigned char* lds, const Cx& c) {
    const int nlat = NB * 8 * 4;
    const int total = 3 * nlat + (c.l == 0 ? NB * 24 : 0);
    for (int i = 0;; ++i) {
        const int L = i * c.G + c.vcu; if (L >= total) break;
        int type, bl, head, q0, nq, kb0, kb1;
        if (L < 3 * nlat) { type = L / nlat; const int r = L - type * nlat; bl = r >> 5; head = (r >> 2) & 7; const int qb = r & 3; q0 = CTXL + qb * 512; nq = 512; kb0 = 4; kb1 = 36;
            if (type == 2) {
                const int kvh = (r >> 4) & 1, qb16 = r & 15; head = kvh * 4; q0 = CTXL + qb16 * 128; nq = 128;
                const int t0 = qb16 * 2; kb0 = 4 + (t0 - 2 < 0 ? 0 : t0 - 2); kb1 = 4 + (t0 + 4 > 32 ? 32 : t0 + 4); } }
        else { const int r = L - 3 * nlat; bl = r / 24; const int hh = r - bl * 24; type = hh >> 3; head = hh & 7; q0 = 0; nq = 256; kb0 = 4; kb1 = 4; }
        const size_t rb = (size_t)bl * SROWS;
        if (type == 0) {
            attn_unit<96>(lds, c.bp(OFF_QM) + rb * 768 + head * 96, 768, c.bp(OFF_KM) + rb * 768 + head * 96, 768,
                          c.bp(OFF_VMT) + ((size_t)(bl * 8 + head) * 64) * SROWS, c.bp(OFF_Z) + rb * 1536 + head * 64, q0, nq, kb0, kb1, false, -1e30f, 0.f, c.tid);
        } else if (type == 1) {
            attn_unit<64>(lds, c.bp(OFF_QA) + rb * 512 + head * 64, 512, c.bp(OFF_KA) + rb * 128 + (head >> 2) * 64, 128,
                          c.bp(OFF_VAT) + ((size_t)(bl * 2 + (head >> 2)) * 64) * SROWS, c.bp(OFF_Z) + rb * 1536 + 1024 + head * 64, q0, nq, kb0, kb1, false, -1e30f, 0.f, c.tid);
        } else {
            const float sk = c.p->swa_sink[c.l * 8 + head] * LOG2E;
            attn_unit<64>(lds, c.bp(OFF_QS) + rb * 512 + head * 64, 512, c.bp(OFF_KS) + rb * 128 + (head >> 2) * 64, 128,
                          c.bp(OFF_VST) + ((size_t)(bl * 2 + (head >> 2)) * 64) * SROWS, c.bp(OFF_Z) + rb * 1536 + 512 + head * 64, q0, nq, kb0, kb1, nq == 128, 0.f, ex2(sk), c.tid, nq == 128, c.p->swa_sink + c.l * 8 + head);
        }
    }
}

__device__ __forceinline__ int orig32(int s) { const int half = s >> 4, t = s & 15; return (t >> 3) * 16 + half * 8 + (t & 7); }
__device__ __forceinline__ int colmap1(int n) {
    const int t = n >> 8, r = n & 255;
    switch (t) {
    case 0: return permrow(r);
    case 1: return 800 + permrow(r);
    case 2: return r < 128 ? 1056 + permrow(r) : (r < 160 ? 256 + orig32(r - 128) : -1);
    case 3: { const int bj = r >> 7, wc = (r >> 5) & 3, d = bj * 32 + (r & 31); return (wc < 2 ? 288 + wc * 64 : 544 + (wc - 2) * 64) + d; }
    case 4: return r < 128 ? 416 + r : 672 + (r - 128);
    case 5: case 6: case 7: case 8: { const int bj = r >> 7, wc = (r >> 5) & 3, d = bj * 32 + (r & 31); const int head = ((t - 5) & 1) * 4 + wc; return (t < 7 ? 1184 : 1696) + head * 64 + d; }
    default: return t < 15 ? 2208 + (t - 9) * 256 + permrow(r) : 3744 + (t - 15) * 256 + permrow(r);
    }
}
__device__ __forceinline__ int colmap2a(int n) { if (n < 512) return (n >> 6) * 96 + (n & 63); const int r = n - 512; return (r >> 5) * 96 + 64 + orig32(r & 31); }
__device__ __forceinline__ int colmap2b(int n) { if (n < 512) return (n >> 6) * 128 + (n & 63); const int r = n - 512; return (r >> 6) * 128 + 64 + (r & 63); }

__device__ __forceinline__ void prep_phase(LAS unsigned char* lds, const Cx& c) {
    const KParams p_ = c.p; const int tid = c.tid;
    LAS float* lf = (LAS float*)lds;
    for (int u = c.bid; u < 288; u += c.G) {
        const int l = u / 144, rem = u - l * 144, cg64 = rem / 3, sg = rem - cg64 * 3;
        __syncthreads();
        for (int idx = tid; idx < 11 * 1024; idx += 512) { const int r = idx >> 10, k = idx & 1023, gr = sg * 11 + r; const float v = gr < 32 ? p_->c[gr * 1024 + k] : p_->c_ctx[k]; lf[idx] = v * sigm(v); }
        __syncthreads();
        const int col = tid & 63, ks = tid >> 6;
        float a[11];
#pragma unroll
        for (int r = 0; r < 11; ++r) a[r] = 0.f;
        const float* w = p_->ada_w + ((size_t)l * 1024 + ks * 128) * 3072 + cg64 * 64 + col;
        for (int k = 0; k < 128; ++k) { const float wv = w[(size_t)k * 3072];
#pragma unroll
            for (int r = 0; r < 11; ++r) a[r] += lf[r * 1024 + ks * 128 + k] * wv; }
#pragma unroll
        for (int r = 0; r < 11; ++r) lf[11264 + (ks * 11 + r) * 64 + col] = a[r];
        __syncthreads();
        for (int idx = tid; idx < 704; idx += 512) { const int r = idx >> 6, cc = idx & 63; float s = p_->ada_b[l * 3072 + cg64 * 64 + cc];
#pragma unroll
            for (int q = 0; q < 8; ++q) s += lf[11264 + (q * 11 + r) * 64 + cc];
            c.fp(OFF_MODX)[((size_t)l * 33 + sg * 11 + r) * 3072 + cg64 * 64 + cc] = s; }
    }
    for (int u = c.bid; u < 2 * 2504; u += c.G) {
        const int l = u / 2504; int r = u - l * 2504;
        const float* src; const float* ksc = nullptr; bf16_t* dst; int K, Ns, job; float wsc = 1.0f;
        if (r < 1728) { job = 0; src = p_->w_in + (size_t)l * 1024 * INW; Ns = INW; K = 1024; dst = c.bp(OFF_W1) + (size_t)l * N1 * 1024; }
        else if ((r -= 1728) < 72) { job = 1; src = p_->mla_w_uq + (size_t)l * 384 * 768; Ns = 768; K = 384; dst = c.bp(OFF_W2A) + (size_t)l * 768 * 384; ksc = p_->mla_q_norm + l * 384; }
        else if ((r -= 72) < 64) { job = 2; src = p_->mla_w_ukv + (size_t)l * 256 * 1024; Ns = 1024; K = 256; dst = c.bp(OFF_W2B) + (size_t)l * 1024 * 256; ksc = p_->mla_kv_norm + l * 256; }
        else if ((r -= 64) < 384) { job = 3; const int br = r >> 7; r &= 127; src = (br == 0 ? p_->w_o_mla : br == 1 ? p_->w_o_swa : p_->w_o_ax) + (size_t)l * 512 * 1024; Ns = 1024; K = 512; dst = c.bp(OFF_W3) + ((size_t)l * 3 + br) * 1024 * 512; wsc = -0.6931471805599453f; }
        else { r -= 384; job = 3; src = p_->w_out + (size_t)l * 1024 * 1024; Ns = 1024; K = 1024; dst = c.bp(OFF_W4) + (size_t)l * 1024 * 1024; }
        const int nkt = K >> 6, n0 = (r / nkt) * 64, k0 = (r % nkt) * 64;
        if (job == 0 && n0 >= 9 * 256) wsc = -LOG2E;
        __syncthreads();
        { const int nl = tid & 63; const int n = n0 + nl; const int sc = job == 0 ? colmap1(n) : job == 1 ? colmap2a(n) : job == 2 ? colmap2b(n) : permrow(n);
#pragma unroll
          for (int i = 0; i < 8; ++i) { const int kl = (tid >> 6) + 8 * i; float v = sc >= 0 ? src[(size_t)(k0 + kl) * Ns + sc] : 0.f; if (ksc) v *= ksc[k0 + kl]; lf[nl * 65 + kl] = v * wsc; } }
        __syncthreads();
        { const int nl = tid >> 3, kc = tid & 7; const LAS float* t = lf + nl * 65 + kc * 8;
          u32x4 w; w.x = pk(t[0], t[1]); w.y = pk(t[2], t[3]); w.z = pk(t[4], t[5]); w.w = pk(t[6], t[7]);
          *(u32x4*)(dst + (size_t)(n0 + nl) * K + k0 + kc * 8) = w; }
    }
}

__device__ __forceinline__ float wave_sum(float v) { v += __shfl_xor(v, 32); v += __shfl_xor(v, 16); v += __shfl_xor(v, 8); v += __shfl_xor(v, 4); v += __shfl_xor(v, 2); v += __shfl_xor(v, 1); return v; }
__device__ __forceinline__ void modnorm_phase(const Cx& c) {
    const KParams p_ = c.p; const int wave = c.tid >> 6, lane = c.tid & 63;
    const float* nw = p_->norm_w + c.l * 1024;
    for (int row = c.bid * 8 + wave; row < R; row += c.G * 8) {
        const int bl = row / SROWS, rr = row - bl * SROWS, sample = c.ch * NB + bl;
        const float* src; const float* mod;
        if (rr < CTXL) { src = (c.l == 0 ? p_->ctx : c.fp(OFF_CTX1)) + ((size_t)sample * CTXL + rr) * 1024; mod = c.fp(OFF_MODX) + ((size_t)c.l * 33 + 32) * 3072; }
        else { src = (c.l == 0 ? p_->x : p_->out) + ((size_t)sample * SEQ + rr - CTXL) * 1024; mod = c.fp(OFF_MODX) + ((size_t)c.l * 33 + sample) * 3072; }
        f32x4 v[4], w4[4], sc[4], sh[4]; float s = 0.f;
#pragma unroll
        for (int i = 0; i < 4; ++i) { const int col = i * 256 + lane * 4; v[i] = *(const f32x4*)(src + col); w4[i] = *(const f32x4*)(nw + col); sc[i] = *(const f32x4*)(mod + 1024 + col); sh[i] = *(const f32x4*)(mod + col); }
#pragma unroll
        for (int i = 0; i < 4; ++i) s += sq4(v[i]);
        s = wave_sum(s); const float rs = __builtin_amdgcn_rsqf(s * (1.0f / 1024.0f) + EPS);
        bf16_t* h = c.bp(OFF_H) + (size_t)row * 1024;
#pragma unroll
        for (int i = 0; i < 4; ++i) st4(h + i * 256 + lane * 4, v[i] * rs * w4[i] * (sc[i] + 1.0f) + sh[i]);
    }
}
__device__ __forceinline__ void finalnorm_phase(const Cx& c) {
    const KParams p_ = c.p; const int wave = c.tid >> 6, lane = c.tid & 63;
    f32x4 fw[4];
#pragma unroll
    for (int i = 0; i < 4; ++i) fw[i] = *(const f32x4*)(p_->final_norm_w + i * 256 + lane * 4);
    for (int r = c.bid * 8 + wave; r < NB * SEQ; r += c.G * 8) {
        float* xr = p_->out + ((size_t)c.ch * NB * SEQ + r) * 1024;
        f32x4 v[4]; float s = 0.f;
#pragma unroll
        for (int i = 0; i < 4; ++i) { v[i] = *(const f32x4*)(xr + i * 256 + lane * 4); s += sq4(v[i]); }
        s = wave_sum(s); const float rs = __builtin_amdgcn_rsqf(s * (1.0f / 1024.0f) + EPS);
#pragma unroll
        for (int i = 0; i < 4; ++i) { const int col = i * 256 + lane * 4; *(f32x4*)(xr + col) = v[i] * rs * fw[i]; }
    }
}


#define XB_TMO      128
#define XB_XCNT(j)  (256  + 64 * (j))
#define XB_XSUB(j)  (1280 + 64 * (j))
#define XB_XGEN(j)  (2304 + 64 * (j))
#define XB_TOP      3328
#define XB_TOPGEN   3392
#define XCD_BAR_WORDS 3456
#define XB_SPIN_CAP (1u << 20)
__device__ __forceinline__ unsigned xb_ld(unsigned* p)              { return __hip_atomic_load(p, __ATOMIC_RELAXED, __HIP_MEMORY_SCOPE_AGENT); }
__device__ __forceinline__ unsigned xb_add(unsigned* p, unsigned v) { return __hip_atomic_fetch_add(p, v, __ATOMIC_RELAXED, __HIP_MEMORY_SCOPE_AGENT); }
__device__ __forceinline__ unsigned xb_xcc_id() { return (unsigned)__builtin_amdgcn_s_getreg((3 << 11) | 20) & 0xFu; }
#define XB_SPIN(cond, bar) do { unsigned _sp = 0; while (cond) { __builtin_amdgcn_s_sleep(1); \
    if ((++_sp & 255u) == 0u) { if (xb_ld(&(bar)[XB_TMO])) break; if (_sp > XB_SPIN_CAP) { atomicAdd(&(bar)[XB_TMO], 1u); break; } } } } while (0)
struct XcdBarrier { unsigned* bar; unsigned x; volatile LAS unsigned* st; };
__device__ __forceinline__ XcdBarrier xcd_barrier_post(unsigned* bar, volatile LAS unsigned* st) {
    XcdBarrier b; b.bar = bar; b.x = xb_xcc_id(); b.st = st;
    if (threadIdx.x == 0) (void)xb_add(&bar[XB_XCNT(b.x)], 1u);
    return b;
}
__device__ __forceinline__ void xcd_barrier_complete(unsigned* bar, unsigned x, unsigned& nloc, unsigned& nx) {
    const unsigned G = gridDim.x * gridDim.y * gridDim.z;
    unsigned sum, cnt, mine, sp = 0u;
    for (;;) {
        sum = 0u; cnt = 0u; mine = 0u;
#pragma unroll
        for (unsigned j = 0; j < 16; ++j) { const unsigned c = xb_ld(&bar[XB_XCNT(j)]); sum += c; cnt += (c > 0u) ? 1u : 0u; mine = (j == x) ? c : mine; }
        if (sum == G) break;
        __builtin_amdgcn_s_sleep(1);
        if ((++sp & 255u) == 0u) { if (xb_ld(&bar[XB_TMO])) break; if (sp > XB_SPIN_CAP) { atomicAdd(&bar[XB_TMO], 1u); break; } }
    }
    nloc = mine > 0u ? mine : 1u; nx = cnt > 0u ? cnt : 1u;
}
__device__ __forceinline__ void xcd_barrier(const XcdBarrier& b) {
    asm volatile("s_waitcnt vmcnt(0)" ::: "memory");
    __syncthreads();
    if (threadIdx.x == 0) {
        unsigned* bar = b.bar;
        __builtin_amdgcn_s_waitcnt(0);
        unsigned nloc = b.st[0], nx = b.st[1];
        if (nloc == 0u) { xcd_barrier_complete(bar, b.x, nloc, nx); b.st[0] = nloc; b.st[1] = nx; }
        const unsigned old = xb_add(&bar[XB_XSUB(b.x)], 1u);
        const unsigned gen = old / nloc;
        if (old + 1u == (gen + 1u) * nloc) {
            __builtin_amdgcn_fence(__ATOMIC_RELEASE, "agent");
            asm volatile("s_waitcnt vmcnt(0)" ::: "memory");
            const unsigned og = xb_add(&bar[XB_TOP], 1u);
            const unsigned tg = og / nx;
            if (og + 1u == (tg + 1u) * nx) xb_add(&bar[XB_TOPGEN], 1u);
            else XB_SPIN(xb_ld(&bar[XB_TOPGEN]) == tg, bar);
            __builtin_amdgcn_fence(__ATOMIC_ACQUIRE, "agent");
            xb_add(&bar[XB_XGEN(b.x)], 1u);
            asm volatile("s_waitcnt vmcnt(0)" ::: "memory");
        } else {
            XB_SPIN(xb_ld(&bar[XB_XGEN(b.x)]) == gen, bar);
            __builtin_amdgcn_fence(__ATOMIC_ACQUIRE, "agent");
            asm volatile("s_waitcnt vmcnt(0)" ::: "memory");
        }
    }
    __syncthreads();
}

extern __shared__ __attribute__((aligned(16))) unsigned char smem_raw[];

__global__ void __launch_bounds__(512) fwd_megakernel(Params p) {
    LAS unsigned char* lds = (LAS unsigned char*)smem_raw;
    Cx c; c.G = gridDim.x; c.ch = 0; c.l = 0;
    const int ph_lo = p.ph_lo, ph_hi = p.ph_hi;
    volatile LAS unsigned* bst = (volatile LAS unsigned*)(lds + pg8::STAGE_BYTES);
    unsigned* bar = (unsigned*)(p.ws + OFF_BAR);
    if (threadIdx.x < 2) bst[threadIdx.x] = 0u;
    if (ph_hi - ph_lo > 1 && blockIdx.x == 0) for (int i = threadIdx.x; i < XCD_BAR_WORDS; i += 512) bar[i] = 0u;
    for (int ph = ph_lo; ph < ph_hi; ++ph) {
        {
            KParams kp = (KParams)__builtin_amdgcn_kernarg_segment_ptr(); asm volatile("" : "+s"(kp)); c.p = kp;
            int t_ = threadIdx.x; asm volatile("" : "+v"(t_)); c.tid = t_;
            int b_ = blockIdx.x; asm volatile("" : "+s"(b_)); c.bid = b_; c.vcu = vcu_of(b_, c.G);
        }
        if (ph == 0) prep_phase(lds, c);
        else {
            const int q = ph - 1; c.ch = q / 13; const int s = q - c.ch * 13; c.l = s / 6; const int k = (s == 12) ? 6 : s - c.l * 6; if (s == 12) c.l = 1;
            if (k == 0) modnorm_phase(c);
            else if (k == 1) { const pg8::Gemm g{1024, 1024, 1024}; pg8::gemm_phase(lds, g, SchedP2(c), EpiP2{c}, c.tid); }
            else if (k == 2) { { const pg8::Gemm g{384, 384, 384}; pg8::gemm_phase(lds, g, SchedP3(c, 0), EpiP3{c, 0}, c.tid); }
                               { const pg8::Gemm g{256, 256, 256}; pg8::gemm_phase(lds, g, SchedP3(c, 1), EpiP3{c, 1}, c.tid); } }
            else if (k == 3) attn_phase(lds, c);
            else if (k == 4) { const pg8::Gemm g{1536, 512, 512}; pg8::gemm_phase(lds, g, SchedP5(c), EpiP5{c}, c.tid); }
            else if (k == 5) { const pg8::Gemm g{1024, 1024, 1024}; pg8::gemm_phase(lds, g, SchedP6(c), EpiP6{c}, c.tid); }
            else finalnorm_phase(c);
        }
        if (ph + 1 < ph_hi) {
            unsigned* barp = (unsigned*)(c.p->ws + OFF_BAR);
            if (ph == ph_lo) { cg::this_grid().sync(); (void)xcd_barrier_post(barp, bst); }
            else { XcdBarrier xb; xb.bar = barp; xb.x = xb_xcc_id(); xb.st = bst; xcd_barrier(xb); }
        }
    }
}

constexpr int LDS_BYTES = pg8::STAGE_BYTES + 256;

extern "C" void kernel_launch(void* const* d_in, const int* in_sizes, int n_in, void* d_out, int out_size, void* d_ws, size_t ws_size, hipStream_t stream) {
    static int grid = 0;
    if (grid == 0) {
        if (n_in != 20 || ws_size < WS_END) { fprintf(stderr, "kernel_launch: unexpected inputs (n_in %d, ws %zu < %zu)\n", n_in, ws_size, (size_t)WS_END); grid = -1; return; }
        int dev = 0, cus = 0, per_cu = 0;
        (void)hipGetDevice(&dev); (void)hipDeviceGetAttribute(&cus, hipDeviceAttributeMultiprocessorCount, dev);
        if (hipFuncSetAttribute((const void*)fwd_megakernel, hipFuncAttributeMaxDynamicSharedMemorySize, LDS_BYTES) != hipSuccess) { fprintf(stderr, "kernel_launch: hipFuncSetAttribute failed\n"); grid = -1; return; }
        if (hipOccupancyMaxActiveBlocksPerMultiprocessor(&per_cu, (const void*)fwd_megakernel, 512, LDS_BYTES) != hipSuccess || per_cu < 1) { fprintf(stderr, "kernel_launch: occupancy query says %d\n", per_cu); per_cu = 1; }
        (void)hipGetLastError();
        grid = cus * 1;
        if (grid <= 0) grid = 256;
    }
    if (grid < 0) return;
    Params p{};
    const float** dst = (const float**)&p;
    for (int i = 0; i < 20; ++i) dst[i] = (const float*)d_in[i];
    p.out = (float*)d_out; p.ws = (unsigned char*)d_ws;
#if MULTI_LAUNCH
    for (int ph = 0; ph < NPHASE; ++ph) { p.ph_lo = ph; p.ph_hi = ph + 1; hipLaunchKernelGGL(fwd_megakernel, dim3(grid), dim3(512), LDS_BYTES, stream, p); }
#else
    p.ph_lo = 0; p.ph_hi = NPHASE;
    void* args[] = {&p};
    hipError_t e = hipLaunchCooperativeKernel((const void*)fwd_megakernel, dim3(grid), dim3(512), args, LDS_BYTES, stream);
    if (e != hipSuccess) fprintf(stderr, "cooperative launch failed: %s (grid %d)\n", hipGetErrorString(e), grid);
#endif
}
```

```cpp
#include <hip/hip_runtime.h>
#include <hip/hip_cooperative_groups.h>
#include <cstdio>
#include <cstdint>
namespace cg = cooperative_groups;

#ifndef MULTI_LAUNCH
#define MULTI_LAUNCH 0
#endif

#define LAS __attribute__((address_space(3)))
typedef unsigned short bf16_t;
typedef short bf16x8 __attribute__((ext_vector_type(8)));
typedef float f32x4 __attribute__((ext_vector_type(4)));
typedef unsigned u32x2 __attribute__((ext_vector_type(2)));
typedef unsigned u32x4 __attribute__((ext_vector_type(4)));

constexpr int DM = 1024, NBATCH = 32, SEQ = 2048, CTXL = 256, SROWS = CTXL + SEQ;
constexpr int NB = 16, NCHUNK = NBATCH / NB, R = NB * SROWS;
constexpr int INW = 6816, N1 = 27 * 256;
constexpr float EPS = 1e-6f;
constexpr float LOG2E = 1.4426950408889634f;
constexpr float QS64 = 0.125f * LOG2E;
constexpr float QS96 = 0.10206207261596575f * LOG2E;
constexpr int NPHASE = 1 + NCHUNK * 13;

constexpr size_t al256(size_t x) { return (x + 255) & ~(size_t)255; }
constexpr size_t OFF_BAR  = 4096;
constexpr size_t OFF_MODX = 4096 + 16384;
constexpr size_t OFF_W1   = al256(OFF_MODX + (size_t)2 * 33 * 3072 * 4);
constexpr size_t OFF_W2A  = OFF_W1 + (size_t)2 * N1 * 1024 * 2;
constexpr size_t OFF_W2B  = OFF_W2A + (size_t)2 * 768 * 384 * 2;
constexpr size_t OFF_W3   = OFF_W2B + (size_t)2 * 1024 * 256 * 2;
constexpr size_t OFF_W4   = OFF_W3 + (size_t)2 * 3 * 1024 * 512 * 2;
constexpr size_t OFF_CTX1 = OFF_W4 + (size_t)2 * 1024 * 1024 * 2;
constexpr size_t OFF_H    = OFF_CTX1 + (size_t)8192 * 1024 * 4;
constexpr size_t OFF_CKV  = OFF_H + (size_t)R * 1024 * 2;
constexpr size_t OFF_CQ   = OFF_CKV + (size_t)R * 256 * 2;
constexpr size_t OFF_SS   = OFF_CQ + (size_t)R * 384 * 2;
constexpr size_t OFF_QM   = al256(OFF_SS + (size_t)R * 20 * 4);
constexpr size_t OFF_QS   = OFF_QM + (size_t)R * 768 * 2;
constexpr size_t OFF_QA   = OFF_QS + (size_t)R * 512 * 2;
constexpr size_t OFF_KM   = OFF_QA + (size_t)R * 512 * 2;
constexpr size_t OFF_VMT  = OFF_KM + (size_t)R * 768 * 2;
constexpr size_t OFF_KS   = OFF_VMT + (size_t)R * 512 * 2;
constexpr size_t OFF_KA   = OFF_KS + (size_t)R * 128 * 2;
constexpr size_t OFF_VST  = OFF_KA + (size_t)R * 128 * 2;
constexpr size_t OFF_VAT  = OFF_VST + (size_t)R * 128 * 2;
constexpr size_t OFF_Z    = OFF_VAT + (size_t)R * 128 * 2;
constexpr size_t OFF_G    = OFF_Z + (size_t)R * 1536 * 2;
constexpr size_t WS_END   = OFF_G + (size_t)R * 3072 * 2;

struct Params {
    const float *x, *c, *ctx, *c_ctx, *ada_w, *ada_b, *norm_w, *w_in, *mla_q_norm, *mla_w_uq, *mla_kv_norm, *mla_w_ukv,
                *swa_sink, *ax_q_norm, *ax_k_norm, *w_o_mla, *w_o_swa, *w_o_ax, *w_out, *final_norm_w;
    float* out; unsigned char* ws; int ph_lo, ph_hi;
};

typedef __bf16 bf16x2_t __attribute__((ext_vector_type(2)));
typedef float f32x2_t __attribute__((ext_vector_type(2)));
__device__ __forceinline__ unsigned pk(float lo, float hi) { const f32x2_t v = {lo, hi}; const bf16x2_t b = __builtin_convertvector(v, bf16x2_t); return __builtin_bit_cast(unsigned, b); }
__device__ __forceinline__ float bflo(unsigned w) { return __builtin_bit_cast(float, w << 16); }
__device__ __forceinline__ float bfhi(unsigned w) { return __builtin_bit_cast(float, w & 0xffff0000u); }
__device__ __forceinline__ void st4(bf16_t* p, f32x4 v) { u32x2 w; w.x = pk(v[0], v[1]); w.y = pk(v[2], v[3]); *(u32x2*)p = w; }
__device__ __forceinline__ f32x4 ld4(const bf16_t* p) { const u32x2 w = *(const u32x2*)p; return (f32x4){bflo(w.x), bfhi(w.x), bflo(w.y), bfhi(w.y)}; }
__device__ __forceinline__ void st8(bf16_t* p, f32x4 a, f32x4 b) { u32x4 w; w.x = pk(a[0], a[1]); w.y = pk(a[2], a[3]); w.z = pk(b[0], b[1]); w.w = pk(b[2], b[3]); *(u32x4*)p = w; }
__device__ __forceinline__ void ld8(const bf16_t* p, f32x4& a, f32x4& b) { const u32x4 w = *(const u32x4*)p; a = (f32x4){bflo(w.x), bfhi(w.x), bflo(w.y), bfhi(w.y)}; b = (f32x4){bflo(w.z), bfhi(w.z), bflo(w.w), bfhi(w.w)}; }
__device__ __forceinline__ int perm32(int rho) { const int n = rho >> 4, i = rho & 15; return 8 * (i >> 2) + 4 * n + (i & 3); }
__device__ __forceinline__ int permrow(int r) { return (r & ~31) + perm32(r & 31); }
__device__ __forceinline__ float ex2(float x) { return __builtin_amdgcn_exp2f(x); }
__device__ __forceinline__ float sigm(float x) { return __builtin_amdgcn_rcpf(1.0f + ex2(-x * LOG2E)); }
__device__ __forceinline__ float xsum4(float s) { s += __shfl_xor(s, 16); s += __shfl_xor(s, 32); return s; }
__device__ __forceinline__ float sq4(f32x4 v) { return (v[0] * v[0] + v[1] * v[1]) + (v[2] * v[2] + v[3] * v[3]); }
__device__ __forceinline__ float vmax3(float a, float b, float c) { float r; asm("v_max3_f32 %0, %1, %2, %3" : "=v"(r) : "v"(a), "v"(b), "v"(c)); return r; }
__device__ __forceinline__ float vmax2(float a, float b) { float r; asm("v_max_f32 %0, %1, %2" : "=v"(r) : "v"(a), "v"(b)); return r; }
__device__ __forceinline__ int vcu_of(int c, int G) { return (G == 256) ? ((c & 7) * 32 + (c >> 3)) : c; }

__device__ __forceinline__ void rot4(f32x4& x1, f32x4& x2, float pos, int idx0, float fexp) {
#pragma unroll
    for (int j = 0; j < 4; ++j) {
        const float f = ex2(-(float)(idx0 + j) * fexp), a = pos * f, cs = __cosf(a), sn = __sinf(a);
        const float a1 = x1[j], a2 = x2[j];
        x1[j] = a1 * cs - a2 * sn; x2[j] = a1 * sn + a2 * cs;
    }
}
constexpr float FEXP16 = 0.83048202372184058f;
constexpr float FEXP8  = 1.66096404744368117f;

namespace pg8 {
constexpr int BM = 256, BK = 64, HALF = 128, HTB = HALF * BK * 2, STAGE_BYTES = 8 * HTB;
__device__ __forceinline__ int lds_byte(int r, int c) { const int st = (r >> 4) * 2 + (c >> 5), rr = r & 15, cc = c & 31, ob = rr * 64 + cc * 2; return st * 1024 + (ob ^ (((ob >> 9) & 1) << 5)); }
__device__ __forceinline__ void stage_rc(int b, int& Rr, int& C) { const int st = b / 1024, sb = b % 1024, swz = sb ^ (((sb >> 9) & 1) << 5); Rr = (st >> 1) * 16 + swz / 64; C = (st & 1) * 32 + (swz % 64) / 2; }

struct Unit { const char* a; const char* b; int p0, p1, p2, p3; };
struct Gemm { int lda, ldb, K; };

template <class Epi, class Sched>
__device__ __forceinline__ void gemm_phase(LAS unsigned char* lds, const Gemm g, const Sched& S, const Epi& E, const int tid) {
    const int wid = __builtin_amdgcn_readfirstlane(tid >> 6), lane = tid & 63, wr = wid >> 2, wc = wid & 3, fr = lane & 15, fq = lane >> 4;
    const int K = g.K, nt = K / BK;
    unsigned voffA[2], voffB[2];
#pragma unroll
    for (int i = 0; i < 2; ++i) { int Rr, C; stage_rc(tid * 16 + i * 8192, Rr, C); voffA[i] = (unsigned)(Rr * g.lda + C) * 2u; voffB[i] = (unsigned)(Rr * g.ldb + C) * 2u; }
    const size_t kstep = (size_t)(BK * 2);
    const size_t hstepA = (size_t)HALF * g.lda * 2, hstepB = (size_t)HALF * g.ldb * 2;
    const unsigned ldsw = (unsigned)wid * 1024u;
    const int aoff = lds_byte(wr * 64 + fr, fq * 8), boff = lds_byte(wc * 32 + fr, fq * 8);
#define PG8_SA(b, h) (((b) * 2 + (h)) * HTB)
#define PG8_SB(b, h) ((4 + (b) * 2 + (h)) * HTB)
#define PG8_STAGE(bufoff, gbase, voff) do { _Pragma("unroll") for (int _i = 0; _i < 2; ++_i) \
        __builtin_amdgcn_global_load_lds((const unsigned*)((const char*)(gbase) + (voff)[_i]), (LAS unsigned*)(lds + (bufoff) + ldsw + _i * 8192), 16, 0, 0); } while (0)
#define PG8_LDA(dst, b, h) do { _Pragma("unroll") for (int m = 0; m < 4; ++m) _Pragma("unroll") for (int k = 0; k < 2; ++k) dst[m][k] = *(const LAS bf16x8*)(lds + PG8_SA(b, h) + aoff + m * 2048 + k * 1024); } while (0)
#define PG8_LDB(dst, b, h) do { _Pragma("unroll") for (int n = 0; n < 2; ++n) _Pragma("unroll") for (int k = 0; k < 2; ++k) dst[n][k] = *(const LAS bf16x8*)(lds + PG8_SB(b, h) + boff + n * 2048 + k * 1024); } while (0)
#define PG8_MMA(ai, bj, At, Bt) do { __builtin_amdgcn_s_setprio(1); _Pragma("unroll") for (int m = 0; m < 4; ++m) _Pragma("unroll") for (int n = 0; n < 2; ++n) _Pragma("unroll") for (int k = 0; k < 2; ++k) \
        acc[ai][bj][m][n] = __builtin_amdgcn_mfma_f32_16x16x32_bf16(Bt[n][k], At[m][k], acc[ai][bj][m][n], 0, 0, 0); __builtin_amdgcn_s_setprio(0); } while (0)
#define PG8_WAIT_V(n) asm volatile("s_waitcnt vmcnt(" #n ")" ::: "memory")
#define PG8_WAIT_L(n) asm volatile("s_waitcnt lgkmcnt(" #n ")" ::: "memory")
#define PG8_BAR __builtin_amdgcn_s_barrier()
#define PG8_SCHED __builtin_amdgcn_sched_barrier(0)
    Unit cur, nxt; int ui = 0;
    if (!S.next(0, cur)) return;
    f32x4 acc[2][2][4][2];
#pragma unroll
    for (int a = 0; a < 2; ++a)
#pragma unroll
        for (int b = 0; b < 2; ++b)
#pragma unroll
            for (int m = 0; m < 4; ++m)
#pragma unroll
                for (int n = 0; n < 2; ++n) acc[a][b][m][n] = (f32x4){0.f, 0.f, 0.f, 0.f};
    bf16x8 At[4][2], B0[2][2], B1[2][2];
    const char* cA = cur.a; const char* cB = cur.b;
    asm volatile("s_waitcnt vmcnt(0)" ::: "memory");
    PG8_STAGE(PG8_SB(0, 0), cB, voffB); PG8_STAGE(PG8_SB(0, 1), cB + hstepB, voffB); PG8_STAGE(PG8_SA(0, 0), cA, voffA); PG8_STAGE(PG8_SA(0, 1), cA + hstepA, voffA);
    if (wr == 1) PG8_BAR;
    PG8_WAIT_V(2); PG8_BAR;
    PG8_STAGE(PG8_SB(1, 0), cB + kstep, voffB); PG8_STAGE(PG8_SA(1, 0), cA + kstep, voffA); PG8_STAGE(PG8_SB(1, 1), cB + hstepB + kstep, voffB);
    PG8_WAIT_V(6); PG8_BAR;
    for (;;) {
        const bool has_next = S.next(ui + 1, nxt);
        const char* nA = has_next ? nxt.a : cA; const char* nB = has_next ? nxt.b : cB;
        for (int t = 0; t < nt; t += 2) {
            const bool last = (t == nt - 2);
            const char* a1 = cA + (size_t)(t + 1) * kstep;
            const char* a2 = last ? nA : cA + (size_t)(t + 2) * kstep; const char* b2 = last ? nB : cB + (size_t)(t + 2) * kstep;
            const char* a3 = a2 + kstep; const char* b3 = b2 + kstep;
            PG8_LDB(B0, 0, 0); PG8_LDB(B1, 0, 1); PG8_SCHED; PG8_LDA(At, 0, 0); PG8_STAGE(PG8_SA(1, 1), a1 + hstepA, voffA);
            PG8_WAIT_V(8); PG8_WAIT_L(0); PG8_BAR; PG8_MMA(0, 0, At, B0); PG8_MMA(0, 1, At, B1); PG8_BAR; PG8_SCHED;
            PG8_LDA(At, 0, 1); PG8_STAGE(PG8_SB(0, 0), b2, voffB); PG8_STAGE(PG8_SB(0, 1), b2 + hstepB, voffB); PG8_STAGE(PG8_SA(0, 0), a2, voffA);
            PG8_WAIT_V(8); PG8_WAIT_L(0); PG8_BAR; PG8_MMA(1, 0, At, B0); PG8_MMA(1, 1, At, B1); PG8_BAR; PG8_SCHED;
            PG8_LDB(B0, 1, 0); PG8_LDB(B1, 1, 1); PG8_SCHED; PG8_LDA(At, 1, 0); PG8_STAGE(PG8_SA(0, 1), a2 + hstepA, voffA);
            PG8_WAIT_V(8); PG8_WAIT_L(0); PG8_BAR; PG8_MMA(0, 0, At, B0); PG8_MMA(0, 1, At, B1); PG8_BAR; PG8_SCHED;
            PG8_LDA(At, 1, 1); PG8_STAGE(PG8_SB(1, 0), b3, voffB); PG8_STAGE(PG8_SB(1, 1), b3 + hstepB, voffB); PG8_STAGE(PG8_SA(1, 0), a3, voffA);
            PG8_WAIT_V(8); PG8_WAIT_L(0); PG8_BAR; PG8_MMA(1, 0, At, B0); PG8_MMA(1, 1, At, B1); PG8_BAR; PG8_SCHED;
        }
        if (wr == 0) PG8_BAR;
        E(acc, cur, wr, wc, fr, fq);
        if (!has_next) break;
        if (!E.keep(cur)) {
#pragma unroll
        for (int a = 0; a < 2; ++a)
#pragma unroll
            for (int b = 0; b < 2; ++b)
#pragma unroll
                for (int m = 0; m < 4; ++m)
#pragma unroll
                    for (int n = 0; n < 2; ++n) acc[a][b][m][n] = (f32x4){0.f, 0.f, 0.f, 0.f};
        }
        cur = nxt; cA = nA; cB = nB; ++ui;
        if (wr == 1) PG8_BAR;
    }
    PG8_WAIT_V(0);
    PG8_BAR;
#undef PG8_SA
#undef PG8_SB
#undef PG8_STAGE
#undef PG8_LDA
#undef PG8_LDB
#undef PG8_MMA
#undef PG8_WAIT_V
#undef PG8_WAIT_L
#undef PG8_BAR
#undef PG8_SCHED
}
}
using pg8::Unit;
typedef const f32x4 (&AccRef)[2][2][4][2];

typedef const __attribute__((address_space(4))) Params* KParams;
struct Cx {
    KParams p; int ch, l, G, vcu, tid, bid;
    __device__ __forceinline__ unsigned char* ws() const { return p->ws; }
    __device__ __forceinline__ bf16_t* bp(size_t off) const { return (bf16_t*)(p->ws + off); }
    __device__ __forceinline__ float* fp(size_t off) const { return (float*)(p->ws + off); }
};

struct SchedP2 {
    Cx c; int total;
    __device__ __forceinline__ SchedP2(const Cx& c_) : c(c_) { total = 128 * 27 + 16 * (c_.l == 0 ? 27 : 4); }
    __device__ __forceinline__ bool next(int i, Unit& u) const {
        const int L = i * c.G + c.vcu; if (L >= total) return false;
        int lt, ct, isctx = 0, rt;
        if (L < 3456) { const int g = L / 24, w = L % 24; lt = (g & 15) * 8 + (w & 7); ct = (g >> 4) * 3 + (w >> 3); rt = (lt >> 3) * 9 + 1 + (lt & 7); }
        else { const int Lc = L - 3456; const int q = Lc >> 4; rt = (Lc & 15) * 9; isctx = 1; ct = (c.l == 0) ? q : (q == 0 ? 0 : q + 1); }
        const char* hrow = (const char*)(c.ws() + OFF_H) + (size_t)rt * 256 * 1024 * 2;
        const char* wrow = (const char*)(c.ws() + OFF_W1) + ((size_t)c.l * N1 + (size_t)ct * 256) * 1024 * 2;
        if (ct == 4) { u.a = wrow; u.b = hrow; } else { u.a = hrow; u.b = wrow; }
        u.p0 = rt * 256; u.p1 = ct; u.p2 = isctx; u.p3 = 0; return true;
    }
};
struct EpiP2 {
    Cx c;
    __device__ __forceinline__ bool keep(const Unit&) const { return false; }
    __device__ __forceinline__ void operator()(AccRef acc, const Unit& u, int wr, int wc, int fr, int fq) const {
        const int row0 = u.p0, ct = u.p1; const bool isctx = u.p2 != 0; const int l = c.l;
        const int bl = row0 / SROWS, rr0 = row0 - bl * SROWS;
        if (ct <= 2) {
            bf16_t* ckv = c.bp(OFF_CKV); bf16_t* cq = c.bp(OFF_CQ); float* ss = c.fp(OFF_SS); bf16_t* km = c.bp(OFF_KM);
#pragma unroll
            for (int ai = 0; ai < 2; ++ai)
#pragma unroll
                for (int m = 0; m < 4; ++m) {
                    const int rl = ai * 128 + wr * 64 + m * 16 + fr; const size_t row = (size_t)(row0 + rl);
#pragma unroll
                    for (int bj = 0; bj < 2; ++bj) {
                        f32x4 v0 = acc[ai][bj][m][0], v1 = acc[ai][bj][m][1];
                        const int col = bj * 128 + wc * 32 + 4 * fq;
                        if (ct == 2 && bj == 1) {
                            if (wc == 0) {
                                if (!isctx) { const int t = rr0 + rl - CTXL; const float pos = (fq >> 1) ? (float)(t & 63) : (float)(t >> 6); rot4(v0, v1, pos, (4 * fq) & 7, FEXP8); }
#pragma unroll
                                for (int h = 0; h < 8; ++h) { st4(km + row * 768 + h * 96 + 64 + 4 * fq, v0); st4(km + row * 768 + h * 96 + 80 + 4 * fq, v1); }
                            }
                        } else {
                            const float s = xsum4(sq4(v0) + sq4(v1));
                            const int colp = bj * 128 + wc * 32 + 8 * fq;
                            if (ct == 0) { st8(ckv + row * 256 + colp, v0, v1); if (fq == 0) ss[row * 20 + bj * 4 + wc] = s; }
                            else if (ct == 1) { st8(cq + row * 384 + colp, v0, v1); if (fq == 0) ss[row * 20 + 8 + bj * 4 + wc] = s; }
                            else { st8(cq + row * 384 + 256 + colp, v0, v1); if (fq == 0) ss[row * 20 + 16 + wc] = s; }
                        }
                    }
                    asm volatile("" ::: "memory");
                }
        } else if (ct == 3 || (ct >= 5 && ct <= 8)) {
            bf16_t* dst; int ld, hcol; bool nrm; const float* nw = nullptr; float qs = 1.0f;
            if (ct == 3) { nrm = (wc >> 1) != 0; dst = c.bp(nrm ? OFF_KA : OFF_KS); ld = 128; hcol = (wc & 1) * 64; nw = c.p->ax_k_norm + l * 64; }
            else if (ct <= 6) { nrm = false; dst = c.bp(OFF_QS); ld = 512; hcol = ((ct - 5) * 4 + wc) * 64; qs = QS64; }
            else { nrm = true; dst = c.bp(OFF_QA); ld = 512; hcol = ((ct - 7) * 4 + wc) * 64; qs = QS64; nw = c.p->ax_q_norm + l * 64; }
            f32x4 w4[2][2];
#pragma unroll
            for (int bj = 0; bj < 2; ++bj)
#pragma unroll
                for (int n = 0; n < 2; ++n) w4[bj][n] = nrm ? *(const f32x4*)(nw + bj * 32 + n * 16 + 4 * fq) : (f32x4){1.f, 1.f, 1.f, 1.f};
#pragma unroll
            for (int ai = 0; ai < 2; ++ai)
#pragma unroll
                for (int m = 0; m < 4; ++m) {
                    const int rl = ai * 128 + wr * 64 + m * 16 + fr; const size_t row = (size_t)(row0 + rl);
                    f32x4 v[2][2];
#pragma unroll
                    for (int bj = 0; bj < 2; ++bj) { v[bj][0] = acc[ai][bj][m][0]; v[bj][1] = acc[ai][bj][m][1]; }
                    if (nrm) {
                        const float s = xsum4((sq4(v[0][0]) + sq4(v[0][1])) + (sq4(v[1][0]) + sq4(v[1][1])));
                        const float rn = __builtin_amdgcn_rsqf(s * (1.0f / 64.0f) + EPS);
#pragma unroll
                        for (int bj = 0; bj < 2; ++bj)
#pragma unroll
                            for (int n = 0; n < 2; ++n) v[bj][n] = v[bj][n] * rn * w4[bj][n];
                    }
                    if (!isctx) {
                        const int t = rr0 + rl - CTXL;
                        rot4(v[0][0], v[0][1], (float)(t >> 6), 4 * fq, FEXP16);
                        rot4(v[1][0], v[1][1], (float)(t & 63), 4 * fq, FEXP16);
                    }
#pragma unroll
                    for (int bj = 0; bj < 2; ++bj)
#pragma unroll
                        for (int n = 0; n < 2; ++n) st4(dst + row * ld + hcol + bj * 32 + n * 16 + 4 * fq, v[bj][n] * qs);
                    asm volatile("" ::: "memory");
                }
        } else if (ct == 4) {
#pragma unroll
            for (int ai = 0; ai < 2; ++ai) {
                bf16_t* vt = c.bp(ai ? OFF_VAT : OFF_VST) + ((size_t)(bl * 2 + wr) * 64) * SROWS + rr0;
#pragma unroll
                for (int m = 0; m < 4; ++m) {
                    const int d = m * 16 + fr;
#pragma unroll
                    for (int bj = 0; bj < 2; ++bj)
#pragma unroll
                        for (int n = 0; n < 2; ++n) st4(vt + (size_t)d * SROWS + bj * 128 + wc * 32 + n * 16 + 4 * fq, acc[ai][bj][m][n]);
                }
            }
        } else {
            const bool isz = ct < 15; bf16_t* dst = c.bp(isz ? OFF_Z : OFF_G); const int ld = isz ? 1536 : 3072; const int cb = (isz ? (ct - 9) : (ct - 15)) * 256;
            const float zsel = isz ? 1.0f : 0.f, gsel = isz ? 0.f : 1.0f;
#pragma unroll
            for (int ai = 0; ai < 2; ++ai)
#pragma unroll
                for (int m = 0; m < 4; ++m) {
                    const size_t row = (size_t)(row0 + ai * 128 + wr * 64 + m * 16 + fr);
#pragma unroll
                    for (int bj = 0; bj < 2; ++bj) {
                        f32x4 v0 = acc[ai][bj][m][0], v1 = acc[ai][bj][m][1];
#pragma unroll
                        for (int j = 0; j < 4; ++j) { v0[j] = __builtin_amdgcn_rcpf(1.0f + ex2(v0[j])) * (zsel * v0[j] + gsel); v1[j] = __builtin_amdgcn_rcpf(1.0f + ex2(v1[j])) * (zsel * v1[j] + gsel); }
                        st8(dst + row * ld + cb + bj * 128 + wc * 32 + 8 * fq, v0, v1);
                    }
                    asm volatile("" ::: "memory");
                }
        }
    }
};

struct SchedP3 {
    Cx c; int which, total, nrt;
    __device__ __forceinline__ SchedP3(const Cx& c_, int w) : c(c_), which(w) { nrt = (w == 1) ? 144 : (c_.l == 0 ? 144 : 128); total = nrt * (w ? 4 : 3); }
    __device__ __forceinline__ bool next(int i, Unit& u) const {
        const int L = i * c.G + c.vcu; if (L >= total) return false;
        const int nct = which ? 4 : 3; const int ri = L / nct, ct = L - ri * nct;
        int rt, isctx = 0;
        if (ri < 128) rt = (ri >> 3) * 9 + 1 + (ri & 7); else { rt = (ri - 128) * 9; isctx = 1; }
        if (which == 0) {
            u.a = (const char*)(c.ws() + OFF_CQ) + (size_t)rt * 256 * 384 * 2;
            u.b = (const char*)(c.ws() + OFF_W2A) + ((size_t)c.l * 768 + (size_t)ct * 256) * 384 * 2;
        } else {
            const char* arow = (const char*)(c.ws() + OFF_CKV) + (size_t)rt * 256 * 256 * 2;
            const char* wrow = (const char*)(c.ws() + OFF_W2B) + ((size_t)c.l * 1024 + (size_t)ct * 256) * 256 * 2;
            if (ct >= 2) { u.a = wrow; u.b = arow; } else { u.a = arow; u.b = wrow; }
        }
        u.p0 = rt * 256; u.p1 = ct; u.p2 = isctx; u.p3 = 0; return true;
    }
};
struct EpiP3 {
    Cx c; int which;
    __device__ __forceinline__ bool keep(const Unit&) const { return false; }
    __device__ __forceinline__ void operator()(AccRef acc, const Unit& u, int wr, int wc, int fr, int fq) const {
        const int row0 = u.p0, ct = u.p1; const bool isctx = u.p2 != 0;
        const int bl = row0 / SROWS, rr0 = row0 - bl * SROWS;
        const float* ss = c.fp(OFF_SS);
        if (which == 0) {
            bf16_t* qm = c.bp(OFF_QM);
#pragma unroll
            for (int ai = 0; ai < 2; ++ai) {
              float rsv[4];
#pragma unroll
              for (int m = 0; m < 4; ++m) {
                    const size_t row = (size_t)(row0 + ai * 128 + wr * 64 + m * 16 + fr);
                    const f32x4 s0 = *(const f32x4*)(ss + row * 20 + 8), s1 = *(const f32x4*)(ss + row * 20 + 12), s2 = *(const f32x4*)(ss + row * 20 + 16);
                    const float sum = ((s0[0] + s0[1]) + (s0[2] + s0[3])) + ((s1[0] + s1[1]) + (s1[2] + s1[3])) + ((s2[0] + s2[1]) + (s2[2] + s2[3]));
                    rsv[m] = __builtin_amdgcn_rsqf(sum * (1.0f / 384.0f) + EPS) * QS96;
              }
              asm volatile("" ::: "memory");
#pragma unroll
                for (int m = 0; m < 4; ++m) {
                    const int rl = ai * 128 + wr * 64 + m * 16 + fr; const size_t row = (size_t)(row0 + rl);
                    const float rs = rsv[m];
#pragma unroll
                    for (int bj = 0; bj < 2; ++bj) {
                        f32x4 v0 = acc[ai][bj][m][0] * rs, v1 = acc[ai][bj][m][1] * rs;
                        if (ct < 2) {
                            const int head = ct * 4 + bj * 2 + (wc >> 1), d = (wc & 1) * 32 + 4 * fq;
                            st4(qm + row * 768 + head * 96 + d, v0); st4(qm + row * 768 + head * 96 + d + 16, v1);
                        } else {
                            const int head = bj * 4 + wc;
                            if (!isctx) { const int t = rr0 + rl - CTXL; const float pos = (fq >> 1) ? (float)(t & 63) : (float)(t >> 6); rot4(v0, v1, pos, (4 * fq) & 7, FEXP8); }
                            st4(qm + row * 768 + head * 96 + 64 + 4 * fq, v0); st4(qm + row * 768 + head * 96 + 80 + 4 * fq, v1);
                        }
                    }
                }
              asm volatile("" ::: "memory");
            }
        } else if (ct < 2) {
            bf16_t* km = c.bp(OFF_KM);
#pragma unroll
            for (int ai = 0; ai < 2; ++ai) {
              float rsv[4];
#pragma unroll
              for (int m = 0; m < 4; ++m) {
                    const size_t row = (size_t)(row0 + ai * 128 + wr * 64 + m * 16 + fr);
                    const f32x4 s0 = *(const f32x4*)(ss + row * 20), s1 = *(const f32x4*)(ss + row * 20 + 4);
                    const float sum = ((s0[0] + s0[1]) + (s0[2] + s0[3])) + ((s1[0] + s1[1]) + (s1[2] + s1[3]));
                    rsv[m] = __builtin_amdgcn_rsqf(sum * (1.0f / 256.0f) + EPS);
              }
              asm volatile("" ::: "memory");
#pragma unroll
                for (int m = 0; m < 4; ++m) {
                    const int rl = ai * 128 + wr * 64 + m * 16 + fr; const size_t row = (size_t)(row0 + rl);
                    const float rs = rsv[m];
#pragma unroll
                    for (int bj = 0; bj < 2; ++bj) {
                        const int head = ct * 4 + bj * 2 + (wc >> 1), d = (wc & 1) * 32 + 4 * fq;
                        st4(km + row * 768 + head * 96 + d, acc[ai][bj][m][0] * rs); st4(km + row * 768 + head * 96 + d + 16, acc[ai][bj][m][1] * rs);
                    }
                }
              asm volatile("" ::: "memory");
            }
        } else {
#pragma unroll
            for (int bj = 0; bj < 2; ++bj)
#pragma unroll
                for (int n = 0; n < 2; ++n) {
                    const int tl = bj * 128 + wc * 32 + n * 16 + 4 * fq;
                    f32x4 rs;
#pragma unroll
                    for (int j = 0; j < 4; ++j) {
                        const size_t row = (size_t)(row0 + tl + j);
                        const f32x4 s0 = *(const f32x4*)(ss + row * 20), s1 = *(const f32x4*)(ss + row * 20 + 4);
                        const float sum = ((s0[0] + s0[1]) + (s0[2] + s0[3])) + ((s1[0] + s1[1]) + (s1[2] + s1[3]));
                        rs[j] = __builtin_amdgcn_rsqf(sum * (1.0f / 256.0f) + EPS);
                    }
#pragma unroll
                    for (int ai = 0; ai < 2; ++ai) {
                        bf16_t* vt = c.bp(OFF_VMT) + ((size_t)(bl * 8 + (ct - 2) * 4 + ai * 2 + wr) * 64) * SROWS + rr0 + tl;
#pragma unroll
                        for (int m = 0; m < 4; ++m) st4(vt + (size_t)(m * 16 + fr) * SROWS, acc[ai][bj][m][n] * rs);
                    }
                    asm volatile("" ::: "memory");
                }
        }
    }
};

struct SchedP5 {
    Cx c; int ntile;
    __device__ __forceinline__ SchedP5(const Cx& c_) : c(c_) { ntile = (c_.l == 0 ? 144 : 128) * 4; }
    __device__ __forceinline__ bool next(int i, Unit& u) const {
        const int it = i / 3, br = i - it * 3;
        const int L = it * c.G + c.vcu; if (L >= ntile) return false;
        const int ri = L >> 2, ct = L & 3; int rt;
        if (ri < 128) rt = (ri >> 3) * 9 + 1 + (ri & 7); else rt = (ri - 128) * 9;
        u.a = (const char*)(c.ws() + OFF_Z) + ((size_t)rt * 256 * 1536 + (size_t)br * 512) * 2;
        u.b = (const char*)(c.ws() + OFF_W3) + (((size_t)c.l * 3 + br) * 1024 + (size_t)ct * 256) * 512 * 2;
        u.p0 = rt * 256; u.p1 = ct; u.p2 = br; u.p3 = 0; return true;
    }
};
typedef f32x4 (&AccRefM)[2][2][4][2];
struct EpiP5 {
    Cx c;
    __device__ __forceinline__ bool keep(const Unit& u) const { return u.p2 < 2; }
    __device__ __forceinline__ void operator()(AccRefM acc, const Unit& u, int wr, int wc, int fr, int fq) const {
        const int row0 = u.p0, ct = u.p1, br = u.p2;
        bf16_t* y = c.bp(OFF_H); const bf16_t* g = c.bp(OFF_G);
#pragma unroll
        for (int ai = 0; ai < 2; ++ai) {
            u32x4 gw[4][2], hw[4][2];
#pragma unroll
            for (int m = 0; m < 4; ++m)
#pragma unroll
                for (int bj = 0; bj < 2; ++bj) {
                    const size_t row = (size_t)(row0 + ai * 128 + wr * 64 + m * 16 + fr); const int col = ct * 256 + bj * 128 + wc * 32 + 8 * fq;
                    gw[m][bj] = *(const u32x4*)(g + row * 3072 + br * 1024 + col);
                    if (br < 2) hw[m][bj] = *(const u32x4*)(g + row * 3072 + (br + 1) * 1024 + col);
                }
#pragma unroll
            for (int m = 0; m < 4; ++m)
#pragma unroll
                for (int bj = 0; bj < 2; ++bj) {
                    const u32x4 w = gw[m][bj];
                    f32x4 s0 = (f32x4){bflo(w.x), bfhi(w.x), bflo(w.y), bfhi(w.y)}, s1 = (f32x4){bflo(w.z), bfhi(w.z), bflo(w.w), bfhi(w.w)};
                    if (br < 2) {
                        const u32x4 v = hw[m][bj];
                        const f32x4 d0 = (f32x4){bflo(v.x), bfhi(v.x), bflo(v.y), bfhi(v.y)}, d1 = (f32x4){bflo(v.z), bfhi(v.z), bflo(v.w), bfhi(v.w)};
#pragma unroll
                        for (int j = 0; j < 4; ++j) { s0[j] *= __builtin_amdgcn_rcpf(fmaxf(d0[j], 1e-20f)); s1[j] *= __builtin_amdgcn_rcpf(fmaxf(d1[j], 1e-20f)); }
                        acc[ai][bj][m][0] = acc[ai][bj][m][0] * s0; acc[ai][bj][m][1] = acc[ai][bj][m][1] * s1;
                    } else {
                        const size_t row = (size_t)(row0 + ai * 128 + wr * 64 + m * 16 + fr); const int col = ct * 256 + bj * 128 + wc * 32 + 8 * fq;
                        st8(y + row * 1024 + col, acc[ai][bj][m][0] * s0, acc[ai][bj][m][1] * s1);
                    }
                }
            asm volatile("" ::: "memory");
        }
    }
};

struct SchedP6 {
    Cx c; int ntile;
    __device__ __forceinline__ SchedP6(const Cx& c_) : c(c_) { ntile = (c_.l == 0 ? 144 : 128) * 4; }
    __device__ __forceinline__ bool next(int i, Unit& u) const {
        const int L = i * c.G + c.vcu; if (L >= ntile) return false;
        const int ri = L >> 2, ct = L & 3; int rt, isctx = 0, grow;
        if (ri < 128) { rt = (ri >> 3) * 9 + 1 + (ri & 7); grow = (c.ch * NB + (ri >> 3)) * SEQ + (ri & 7) * 256; }
        else { rt = (ri - 128) * 9; isctx = 1; grow = (c.ch * NB + (ri - 128)) * CTXL; }
        u.a = (const char*)(c.ws() + OFF_H) + (size_t)rt * 256 * 1024 * 2;
        u.b = (const char*)(c.ws() + OFF_W4) + ((size_t)c.l * 1024 + (size_t)ct * 256) * 1024 * 2;
        u.p0 = rt * 256; u.p1 = ct; u.p2 = isctx; u.p3 = grow; return true;
    }
};
struct EpiP6 {
    Cx c;
    __device__ __forceinline__ bool keep(const Unit&) const { return false; }
    __device__ __forceinline__ void operator()(AccRef acc, const Unit& u, int wr, int wc, int fr, int fq) const {
        const int ct = u.p1; const bool isctx = u.p2 != 0; const int grow = u.p3;
        const float* src; float* dst; const float* gate;
        if (isctx) { src = c.p->ctx; dst = c.fp(OFF_CTX1); gate = c.fp(OFF_MODX) + ((size_t)c.l * 33 + 32) * 3072 + 2048; }
        else { src = (c.l == 0) ? c.p->x : c.p->out; dst = c.p->out; gate = c.fp(OFF_MODX) + ((size_t)c.l * 33 + (grow >> 11)) * 3072 + 2048; }
#pragma unroll
        for (int bj = 0; bj < 2; ++bj) {
            const int col = ct * 256 + bj * 128 + wc * 32 + 8 * fq;
            const f32x4 gt0 = *(const f32x4*)(gate + col), gt1 = *(const f32x4*)(gate + col + 4);
#pragma unroll
            for (int ai = 0; ai < 2; ++ai) {
                f32x4 xo[4][2];
#pragma unroll
                for (int m = 0; m < 4; ++m) {
                    const size_t row = (size_t)(grow + ai * 128 + wr * 64 + m * 16 + fr);
                    xo[m][0] = *(const f32x4*)(src + row * 1024 + col); xo[m][1] = *(const f32x4*)(src + row * 1024 + col + 4);
                }
#pragma unroll
                for (int m = 0; m < 4; ++m) {
                    const size_t row = (size_t)(grow + ai * 128 + wr * 64 + m * 16 + fr);
                    *(f32x4*)(dst + row * 1024 + col) = xo[m][0] + gt0 * acc[ai][bj][m][0];
                    *(f32x4*)(dst + row * 1024 + col + 4) = xo[m][1] + gt1 * acc[ai][bj][m][1];
                }
                asm volatile("" ::: "memory");
            }
        }
    }
};

constexpr int A_PV = 144, A_KB = 13312, A_STG = A_KB + 64 * A_PV;
template <int DK>
__device__ __forceinline__ void attn_unit(LAS unsigned char* lds, const bf16_t* __restrict__ Qp, int ldq, const bf16_t* __restrict__ Kp, int ldk,
                                          const bf16_t* __restrict__ VTp, bf16_t* Zp, int q0, int nq, int kb0, int kb1, bool swa, float m_init, float l_init_, const int tid, const bool grp = false, const float* sinkp = nullptr) {
    constexpr int KS = DK / 32, PK = DK * 2 + 16, KCH = DK / 8;
    const int wave = __builtin_amdgcn_readfirstlane(tid >> 6), lane = tid & 63, fr = lane & 15, fq = lane >> 4;
    const bool active = grp ? true : (wave * 64 < nq);
    const int qw = q0 + (grp ? (wave & 1) * 64 : wave * 64);
    if (grp) { Qp += (wave >> 1) * 64; Zp += (wave >> 1) * 64; }
    const float l_init = grp ? ex2(sinkp[wave >> 1] * LOG2E) : l_init_;
    constexpr int KSR = (DK == 96) ? 2 : KS;
    constexpr int QL_OFF = 2 * A_STG, QL_PITCH = 80;
    bf16x8 qf[4][KSR];
#pragma unroll
    for (int n = 0; n < 4; ++n)
#pragma unroll
        for (int ks = 0; ks < KSR; ++ks) qf[n][ks] = active ? *(const bf16x8*)(Qp + (size_t)(qw + n * 16 + fr) * ldq + ks * 32 + fq * 8) : (bf16x8){0, 0, 0, 0, 0, 0, 0, 0};
    LAS unsigned char* qlds = lds + QL_OFF + wave * (64 * QL_PITCH);
    if (DK == 96) {
#pragma unroll
        for (int n = 0; n < 4; ++n) {
            const bf16x8 t = active ? *(const bf16x8*)(Qp + (size_t)(qw + n * 16 + fr) * ldq + 64 + fq * 8) : (bf16x8){0, 0, 0, 0, 0, 0, 0, 0};
            *(LAS bf16x8*)(qlds + (n * 16 + fr) * QL_PITCH + fq * 16) = t;
        }
    }
    f32x4 O[4][4];
#pragma unroll
    for (int a = 0; a < 4; ++a)
#pragma unroll
        for (int b = 0; b < 4; ++b) O[a][b] = (f32x4){0.f, 0.f, 0.f, 0.f};
    constexpr bool LMF = (DK == 64);
    float mrun[4], lrun[4]; f32x4 L5[4]; f32x4 negm[4];
    const bf16x8 ones = (bf16x8){0x3F80, 0x3F80, 0x3F80, 0x3F80, 0x3F80, 0x3F80, 0x3F80, 0x3F80};
#pragma unroll
    for (int n = 0; n < 4; ++n) { negm[n] = (f32x4){0.f, 0.f, 0.f, 0.f}; mrun[n] = 0.f; lrun[n] = (fq == 0) ? l_init : 0.f; L5[n] = (f32x4){l_init, l_init, l_init, l_init}; }
    const int nT = 4 + (kb1 - kb0);
    const int kr0 = tid / KCH, kc0 = tid - kr0 * KCH;
    const int t2 = tid + 512; const int kr1 = t2 / KCH, kc1 = t2 - kr1 * KCH;
    const bool k2 = (DK == 96) && (tid < 256);
    const int vr = tid >> 3, vc = tid & 7;
    bf16x8 kreg0, kreg1 = (bf16x8){0, 0, 0, 0, 0, 0, 0, 0}, vreg;
#define A_LOAD(i) do { const int _r0 = (((i) < 4) ? (i) : kb0 + ((i) - 4)) * 64; \
        kreg0 = *(const bf16x8*)(Kp + (size_t)(_r0 + kr0) * ldk + kc0 * 8); \
        if (k2) kreg1 = *(const bf16x8*)(Kp + (size_t)(_r0 + kr1) * ldk + kc1 * 8); \
        vreg = *(const bf16x8*)(VTp + (size_t)vr * SROWS + _r0 + vc * 8); } while (0)
#define A_STORE(buf) do { LAS unsigned char* _b = lds + (buf) * A_STG; \
        *(LAS bf16x8*)(_b + kr0 * PK + kc0 * 16) = kreg0; \
        if (k2) *(LAS bf16x8*)(_b + kr1 * PK + kc1 * 16) = kreg1; \
        *(LAS bf16x8*)(_b + A_KB + vr * A_PV + vc * 16) = vreg; } while (0)
    A_LOAD(0); A_STORE(0);
    __syncthreads();
    for (int i = 0; i < nT; ++i) {
        if (i + 1 < nT) A_LOAD(i + 1);
        const int kt = (i < 4) ? i : kb0 + (i - 4);
        const bool lat = i >= 4;
        const int kl = (kt - 4) * 64, tqw = qw - CTXL;
        bool doit = active;
        if (swa && lat) { if (kl + 63 < tqw - 128 || kl > tqw + 191) doit = false; }
        if (doit) {
            const LAS unsigned char* kbuf = lds + (i & 1) * A_STG; const LAS unsigned char* vbuf = kbuf + A_KB;
#pragma unroll 1
            for (int half = 0; half < 2; ++half) {
                f32x4 S[2][4];
#pragma unroll
                for (int m = 0; m < 2; ++m)
#pragma unroll
                    for (int n = 0; n < 4; ++n) { S[m][n] = negm[n]; }
                const LAS unsigned char* kb = kbuf + (half * 32 + fr) * PK + fq * 16;
#pragma unroll
                for (int ks = 0; ks < KS; ++ks) {
                    const bf16x8 k0 = *(const LAS bf16x8*)(kb + ks * 64);
                    const bf16x8 k1 = *(const LAS bf16x8*)(kb + 16 * PK + ks * 64);
#pragma unroll
                    for (int n = 0; n < 4; ++n) {
                        bf16x8 qv;
                        if (ks < KSR) qv = qf[n][ks < KSR ? ks : 0]; else qv = *(const LAS bf16x8*)(qlds + (n * 16 + fr) * QL_PITCH + fq * 16);
                        S[0][n] = __builtin_amdgcn_mfma_f32_16x16x32_bf16(k0, qv, S[0][n], 0, 0, 0);
                        S[1][n] = __builtin_amdgcn_mfma_f32_16x16x32_bf16(k1, qv, S[1][n], 0, 0, 0);
                    }
                }
                if (swa && lat) {
#pragma unroll
                    for (int m = 0; m < 2; ++m)
#pragma unroll
                        for (int n = 0; n < 4; ++n)
#pragma unroll
                            for (int j = 0; j < 4; ++j) {
                                const int df = (tqw + n * 16 + fr) - (kl + half * 32 + m * 16 + 4 * fq + j);
                                if (df > 128 || df < -128) S[m][n][j] = -1e30f;
                            }
                }
                constexpr bool PREFV = (DK == 64);
                bf16x8 vfp[2];
                if (PREFV) {
#pragma unroll
                    for (int dt = 0; dt < 2; ++dt) {
                        const LAS unsigned char* vp = vbuf + (dt * 16 + fr) * A_PV + (half * 32 + 4 * fq) * 2;
                        const u32x2 lo = *(const LAS u32x2*)vp, hi = *(const LAS u32x2*)(vp + 32);
                        vfp[dt] = __builtin_bit_cast(bf16x8, (u32x4){lo.x, lo.y, hi.x, hi.y});
                    }
                    __builtin_amdgcn_sched_barrier(0);
                }
                asm volatile("s_nop 7\n\ts_nop 3" : "+v"(S[0][0]), "+v"(S[0][1]), "+v"(S[0][2]), "+v"(S[0][3]), "+v"(S[1][0]), "+v"(S[1][1]), "+v"(S[1][2]), "+v"(S[1][3]));
                float lm[4];
#pragma unroll
                for (int n = 0; n < 4; ++n) {
                    if (true) lm[n] = vmax2(vmax3(S[0][n][0], S[0][n][1], S[0][n][2]), vmax3(S[0][n][3], S[1][n][0], vmax3(S[1][n][1], S[1][n][2], S[1][n][3])));
                    else lm[n] = fmaxf(fmaxf(fmaxf(S[0][n][0], S[0][n][1]), fmaxf(S[0][n][2], S[0][n][3])), fmaxf(fmaxf(S[1][n][0], S[1][n][1]), fmaxf(S[1][n][2], S[1][n][3])));
                }
                const bool first = (i == 0) && (half == 0);
                if (first || __builtin_amdgcn_ballot_w64((true ? vmax2(vmax3(lm[0], lm[1], lm[2]), lm[3]) : fmaxf(fmaxf(lm[0], lm[1]), fmaxf(lm[2], lm[3]))) > 8.0f) != 0ull) {
#pragma unroll
                    for (int n = 0; n < 4; ++n) {
                        float mx = lm[n]; mx = fmaxf(mx, __shfl_xor(mx, 16)); mx = fmaxf(mx, __shfl_xor(mx, 32));
                        const float d = first ? mx : fmaxf(mx, 0.f), alpha = ex2(-d);
                        mrun[n] += d; negm[n] = negm[n] - d; if (LMF) L5[n] = L5[n] * alpha; else lrun[n] *= alpha;
#pragma unroll
                        for (int dt = 0; dt < 4; ++dt) O[dt][n] = O[dt][n] * alpha;
                        S[0][n] = S[0][n] - d; S[1][n] = S[1][n] - d;
                    }
                }
                bf16x8 pf[4];
#pragma unroll
                for (int n = 0; n < 4; ++n) {
                    f32x4 p0, p1;
#pragma unroll
                    for (int j = 0; j < 4; ++j) { p0[j] = ex2(S[0][n][j]); p1[j] = ex2(S[1][n][j]); }
                    if (!LMF) lrun[n] += (((p0[0] + p0[1]) + (p0[2] + p0[3])) + ((p1[0] + p1[1]) + (p1[2] + p1[3])));
                    u32x4 w; w.x = pk(p0[0], p0[1]); w.y = pk(p0[2], p0[3]); w.z = pk(p1[0], p1[1]); w.w = pk(p1[2], p1[3]);
                    pf[n] = __builtin_bit_cast(bf16x8, w);
                }
#pragma unroll
                for (int n = 0; n < 4; ++n) if (LMF) L5[n] = __builtin_amdgcn_mfma_f32_16x16x32_bf16(ones, pf[n], L5[n], 0, 0, 0);
#pragma unroll
                for (int dt = 0; dt < 4; ++dt) {
                    const LAS unsigned char* vp = vbuf + (dt * 16 + fr) * A_PV + (half * 32 + 4 * fq) * 2;
                    bf16x8 vf;
                    if (PREFV && dt < 2) vf = vfp[dt];
                    else { const u32x2 lo = *(const LAS u32x2*)vp, hi = *(const LAS u32x2*)(vp + 32); vf = __builtin_bit_cast(bf16x8, (u32x4){lo.x, lo.y, hi.x, hi.y}); }
#pragma unroll
                    for (int n = 0; n < 4; ++n) O[dt][n] = __builtin_amdgcn_mfma_f32_16x16x32_bf16(vf, pf[n], O[dt][n], 0, 0, 0);
                }
            }
        }
        if (i + 1 < nT) A_STORE((i + 1) & 1);
        __syncthreads();
    }
#undef A_LOAD
#undef A_STORE
    if (active) {
        u32x2 zw[4][4];
#pragma unroll
        for (int n = 0; n < 4; ++n)
#pragma unroll
            for (int dt = 0; dt < 4; ++dt) zw[n][dt] = *(const u32x2*)(Zp + (size_t)(qw + n * 16 + fr) * 1536 + 4 * fq + dt * 16);
        asm volatile("" ::: "memory");
#pragma unroll
        for (int n = 0; n < 4; ++n) {
            const float inv = __builtin_amdgcn_rcpf(LMF ? L5[n][0] : xsum4(lrun[n]));
            bf16_t* zr = Zp + (size_t)(qw + n * 16 + fr) * 1536 + 4 * fq;
#pragma unroll
            for (int dt = 0; dt < 4; ++dt) { const u32x2 w = zw[n][dt]; const f32x4 z = (f32x4){bflo(w.x), bfhi(w.x), bflo(w.y), bfhi(w.y)}; st4(zr + dt * 16, O[dt][n] * inv * z); }
        }
    }
}

__device__ __forceinline__ void attn_phase(LAS unsigned char* lds, const Cx& c) {
    const int nlat = NB * 8 * 4;
    const int total = 3 * nlat + (c.l == 0 ? NB * 24 : 0);
    for (int i = 0;; ++i) {
        const int L = i * c.G + c.vcu; if (L >= total) break;
        int type, bl, head, q0, nq, kb0, kb1;
        if (L < 3 * nlat) { type = L / nlat; const int r = L - type * nlat; bl = r >> 5; head = (r >> 2) & 7; const int qb = r & 3; q0 = CTXL + qb * 512; nq = 512; kb0 = 4; kb1 = 36;
            if (type == 2) {
                const int kvh = (r >> 4) & 1, qb16 = r & 15; head = kvh * 4; q0 = CTXL + qb16 * 128; nq = 128;
                const int t0 = qb16 * 2; kb0 = 4 + (t0 - 2 < 0 ? 0 : t0 - 2); kb1 = 4 + (t0 + 4 > 32 ? 32 : t0 + 4); } }
        else { const int r = L - 3 * nlat; bl = r / 24; const int hh = r - bl * 24; type = hh >> 3; head = hh & 7; q0 = 0; nq = 256; kb0 = 4; kb1 = 4; }
        const size_t rb = (size_t)bl * SROWS;
        if (type == 0) {
            attn_unit<96>(lds, c.bp(OFF_QM) + rb * 768 + head * 96, 768, c.bp(OFF_KM) + rb * 768 + head * 96, 768,
                          c.bp(OFF_VMT) + ((size_t)(bl * 8 + head) * 64) * SROWS, c.bp(OFF_Z) + rb * 1536 + head * 64, q0, nq, kb0, kb1, false, -1e30f, 0.f, c.tid);
        } else if (type == 1) {
            attn_unit<64>(lds, c.bp(OFF_QA) + rb * 512 + head * 64, 512, c.bp(OFF_KA) + rb * 128 + (head >> 2) * 64, 128,
                          c.bp(OFF_VAT) + ((size_t)(bl * 2 + (head >> 2)) * 64) * SROWS, c.bp(OFF_Z) + rb * 1536 + 1024 + head * 64, q0, nq, kb0, kb1, false, -1e30f, 0.f, c.tid);
        } else {
            const float sk = c.p->swa_sink[c.l * 8 + head] * LOG2E;
            attn_unit<64>(lds, c.bp(OFF_QS) + rb * 512 + head * 64, 512, c.bp(OFF_KS) + rb * 128 + (head >> 2) * 64, 128,
                          c.bp(OFF_VST) + ((size_t)(bl * 2 + (head >> 2)) * 64) * SROWS, c.bp(OFF_Z) + rb * 1536 + 512 + head * 64, q0, nq, kb0, kb1, nq == 128, 0.f, ex2(sk), c.tid, nq == 128, c.p->swa_sink + c.l * 8 + head);
        }
    }
}

__device__ __forceinline__ int orig32(int s) { const int half = s >> 4, t = s & 15; return (t >> 3) * 16 + half * 8 + (t & 7); }
__device__ __forceinline__ int colmap1(int n) {
    const int t = n >> 8, r = n & 255;
    switch (t) {
    case 0: return permrow(r);
    case 1: return 800 + permrow(r);
    case 2: return r < 128 ? 1056 + permrow(r) : (r < 160 ? 256 + orig32(r - 128) : -1);
    case 3: { const int bj = r >> 7, wc = (r >> 5) & 3, d = bj * 32 + (r & 31); return (wc < 2 ? 288 + wc * 64 : 544 + (wc - 2) * 64) + d; }
    case 4: return r < 128 ? 416 + r : 672 + (r - 128);
    case 5: case 6: case 7: case 8: { const int bj = r >> 7, wc = (r >> 5) & 3, d = bj * 32 + (r & 31); const int head = ((t - 5) & 1) * 4 + wc; return (t < 7 ? 1184 : 1696) + head * 64 + d; }
    default: return t < 15 ? 2208 + (t - 9) * 256 + permrow(r) : 3744 + (t - 15) * 256 + permrow(r);
    }
}
__device__ __forceinline__ int colmap2a(int n) { if (n < 512) return (n >> 6) * 96 + (n & 63); const int r = n - 512; return (r >> 5) * 96 + 64 + orig32(r & 31); }
__device__ __forceinline__ int colmap2b(int n) { if (n < 512) return (n >> 6) * 128 + (n & 63); const int r = n - 512; return (r >> 6) * 128 + 64 + (r & 63); }

struct WTile { const float* src; const float* ksc; bf16_t* dst; int K, Ns, job, n0, k0; float wsc; };
__device__ __forceinline__ void wtile_decode(const Cx& c, int u, WTile& t) {
    const KParams p_ = c.p;
    const int l = u / 2504; int r = u - l * 2504;
    t.ksc = nullptr; t.wsc = 1.0f;
    if (r < 1728) { t.job = 0; t.src = p_->w_in + (size_t)l * 1024 * INW; t.Ns = INW; t.K = 1024; t.dst = c.bp(OFF_W1) + (size_t)l * N1 * 1024; }
    else if ((r -= 1728) < 72) { t.job = 1; t.src = p_->mla_w_uq + (size_t)l * 384 * 768; t.Ns = 768; t.K = 384; t.dst = c.bp(OFF_W2A) + (size_t)l * 768 * 384; t.ksc = p_->mla_q_norm + l * 384; }
    else if ((r -= 72) < 64) { t.job = 2; t.src = p_->mla_w_ukv + (size_t)l * 256 * 1024; t.Ns = 1024; t.K = 256; t.dst = c.bp(OFF_W2B) + (size_t)l * 1024 * 256; t.ksc = p_->mla_kv_norm + l * 256; }
    else if ((r -= 64) < 384) { t.job = 3; const int br = r >> 7; r &= 127; t.src = (br == 0 ? p_->w_o_mla : br == 1 ? p_->w_o_swa : p_->w_o_ax) + (size_t)l * 512 * 1024; t.Ns = 1024; t.K = 512; t.dst = c.bp(OFF_W3) + ((size_t)l * 3 + br) * 1024 * 512; t.wsc = -0.6931471805599453f; }
    else { r -= 384; t.job = 3; t.src = p_->w_out + (size_t)l * 1024 * 1024; t.Ns = 1024; t.K = 1024; t.dst = c.bp(OFF_W4) + (size_t)l * 1024 * 1024; }
    const int nkt = t.K >> 6; t.n0 = (r / nkt) * 64; t.k0 = (r % nkt) * 64;
    if (t.job == 0 && t.n0 >= 9 * 256) t.wsc = -LOG2E;
}
__device__ __forceinline__ void wtile_load(const WTile& t, int tid, float (&vals)[8]) {
    const int nl = tid & 63; const int n = t.n0 + nl; const int sc = t.job == 0 ? colmap1(n) : t.job == 1 ? colmap2a(n) : t.job == 2 ? colmap2b(n) : permrow(n);
#pragma unroll
    for (int i = 0; i < 8; ++i) { const int kl = (tid >> 6) + 8 * i; float v = sc >= 0 ? t.src[(size_t)(t.k0 + kl) * t.Ns + sc] : 0.f; if (t.ksc) v *= t.ksc[t.k0 + kl]; vals[i] = v * t.wsc; }
}
__device__ __forceinline__ void prep_phase(LAS unsigned char* lds, const Cx& c) {
    const bool mode_w = true;
    const KParams p_ = c.p; const int tid = c.tid;
    LAS float* lf = (LAS float*)lds;
    for (int u = c.bid; u < 288; u += c.G) {
        const int l = u / 144, rem = u - l * 144, cg64 = rem / 3, sg = rem - cg64 * 3;
        __syncthreads();
        for (int idx = tid; idx < 11 * 1024; idx += 512) { const int r = idx >> 10, k = idx & 1023, gr = sg * 11 + r; const float v = gr < 32 ? p_->c[gr * 1024 + k] : p_->c_ctx[k]; lf[idx] = v * sigm(v); }
        __syncthreads();
        const int col = tid & 63, ks = tid >> 6;
        float a[11];
#pragma unroll
        for (int r = 0; r < 11; ++r) a[r] = 0.f;
        const float* w = p_->ada_w + ((size_t)l * 1024 + ks * 128) * 3072 + cg64 * 64 + col;
        for (int k = 0; k < 128; ++k) { const float wv = w[(size_t)k * 3072];
#pragma unroll
            for (int r = 0; r < 11; ++r) a[r] += lf[r * 1024 + ks * 128 + k] * wv; }
#pragma unroll
        for (int r = 0; r < 11; ++r) lf[11264 + (ks * 11 + r) * 64 + col] = a[r];
        __syncthreads();
        for (int idx = tid; idx < 704; idx += 512) { const int r = idx >> 6, cc = idx & 63; float s = p_->ada_b[l * 3072 + cg64 * 64 + cc];
#pragma unroll
            for (int q = 0; q < 8; ++q) s += lf[11264 + (q * 11 + r) * 64 + cc];
            c.fp(OFF_MODX)[((size_t)l * 33 + sg * 11 + r) * 3072 + cg64 * 64 + cc] = s; }
    }
    if (mode_w) {
        WTile cur, nxt; float vals[8], nvals[8];
        int u = c.bid;
        bool have = u < 2 * 2504;
        if (have) { wtile_decode(c, u, cur); wtile_load(cur, tid, vals); }
        while (have) {
            __syncthreads();
            { const int nl = tid & 63;
#pragma unroll
              for (int i = 0; i < 8; ++i) lf[nl * 65 + (tid >> 6) + 8 * i] = vals[i]; }
            __syncthreads();
            const int un = u + c.G; const bool hn = un < 2 * 2504;
            if (hn) { wtile_decode(c, un, nxt); wtile_load(nxt, tid, nvals); }
            { const int nl = tid >> 3, kc = tid & 7; const LAS float* t = lf + nl * 65 + kc * 8;
              u32x4 w; w.x = pk(t[0], t[1]); w.y = pk(t[2], t[3]); w.z = pk(t[4], t[5]); w.w = pk(t[6], t[7]);
              *(u32x4*)(cur.dst + (size_t)(cur.n0 + nl) * cur.K + cur.k0 + kc * 8) = w; }
            if (hn) { cur = nxt;
#pragma unroll
                for (int i = 0; i < 8; ++i) vals[i] = nvals[i]; }
            u = un; have = hn;
        }
    }
}

__device__ __forceinline__ float wave_sum(float v) { v += __shfl_xor(v, 32); v += __shfl_xor(v, 16); v += __shfl_xor(v, 8); v += __shfl_xor(v, 4); v += __shfl_xor(v, 2); v += __shfl_xor(v, 1); return v; }
__device__ __forceinline__ void modnorm_phase(const Cx& c) {
    const KParams p_ = c.p; const int wave = c.tid >> 6, lane = c.tid & 63;
    const float* nw = p_->norm_w + c.l * 1024;
    for (int row = c.bid * 8 + wave; row < R; row += c.G * 8) {
        const int bl = row / SROWS, rr = row - bl * SROWS, sample = c.ch * NB + bl;
        const float* src; const float* mod;
        if (rr < CTXL) { src = (c.l == 0 ? p_->ctx : c.fp(OFF_CTX1)) + ((size_t)sample * CTXL + rr) * 1024; mod = c.fp(OFF_MODX) + ((size_t)c.l * 33 + 32) * 3072; }
        else { src = (c.l == 0 ? p_->x : p_->out) + ((size_t)sample * SEQ + rr - CTXL) * 1024; mod = c.fp(OFF_MODX) + ((size_t)c.l * 33 + sample) * 3072; }
        f32x4 v[4], w4[4], sc[4], sh[4]; float s = 0.f;
#pragma unroll
        for (int i = 0; i < 4; ++i) { const int col = i * 256 + lane * 4; v[i] = *(const f32x4*)(src + col); w4[i] = *(const f32x4*)(nw + col); sc[i] = *(const f32x4*)(mod + 1024 + col); sh[i] = *(const f32x4*)(mod + col); }
#pragma unroll
        for (int i = 0; i < 4; ++i) s += sq4(v[i]);
        s = wave_sum(s); const float rs = __builtin_amdgcn_rsqf(s * (1.0f / 1024.0f) + EPS);
        bf16_t* h = c.bp(OFF_H) + (size_t)row * 1024;
#pragma unroll
        for (int i = 0; i < 4; ++i) st4(h + i * 256 + lane * 4, v[i] * rs * w4[i] * (sc[i] + 1.0f) + sh[i]);
    }
}
__device__ __forceinline__ void finalnorm_phase(const Cx& c) {
    const KParams p_ = c.p; const int wave = c.tid >> 6, lane = c.tid & 63;
    f32x4 fw[4];
#pragma unroll
    for (int i = 0; i < 4; ++i) fw[i] = *(const f32x4*)(p_->final_norm_w + i * 256 + lane * 4);
    for (int r = c.bid * 8 + wave; r < NB * SEQ; r += c.G * 8) {
        float* xr = p_->out + ((size_t)c.ch * NB * SEQ + r) * 1024;
        f32x4 v[4]; float s = 0.f;
#pragma unroll
        for (int i = 0; i < 4; ++i) { v[i] = *(const f32x4*)(xr + i * 256 + lane * 4); s += sq4(v[i]); }
        s = wave_sum(s); const float rs = __builtin_amdgcn_rsqf(s * (1.0f / 1024.0f) + EPS);
#pragma unroll
        for (int i = 0; i < 4; ++i) { const int col = i * 256 + lane * 4; *(f32x4*)(xr + col) = v[i] * rs * fw[i]; }
    }
}


#define XB_TMO      128
#define XB_XCNT(j)  (256  + 64 * (j))
#define XB_XSUB(j)  (1280 + 64 * (j))
#define XB_XGEN(j)  (2304 + 64 * (j))
#define XB_TOP      3328
#define XB_TOPGEN   3392
#define XCD_BAR_WORDS 3456
#define XB_SPIN_CAP (1u << 20)
__device__ __forceinline__ unsigned xb_ld(unsigned* p)              { return __hip_atomic_load(p, __ATOMIC_RELAXED, __HIP_MEMORY_SCOPE_AGENT); }
__device__ __forceinline__ unsigned xb_add(unsigned* p, unsigned v) { return __hip_atomic_fetch_add(p, v, __ATOMIC_RELAXED, __HIP_MEMORY_SCOPE_AGENT); }
__device__ __forceinline__ unsigned xb_xcc_id() { return (unsigned)__builtin_amdgcn_s_getreg((3 << 11) | 20) & 0xFu; }
#define XB_SPIN(cond, bar) do { unsigned _sp = 0; while (cond) { __builtin_amdgcn_s_sleep(1); \
    if ((++_sp & 255u) == 0u) { if (xb_ld(&(bar)[XB_TMO])) break; if (_sp > XB_SPIN_CAP) { atomicAdd(&(bar)[XB_TMO], 1u); break; } } } } while (0)
struct XcdBarrier { unsigned* bar; unsigned x; volatile LAS unsigned* st; };
__device__ __forceinline__ XcdBarrier xcd_barrier_post(unsigned* bar, volatile LAS unsigned* st) {
    XcdBarrier b; b.bar = bar; b.x = xb_xcc_id(); b.st = st;
    if (threadIdx.x == 0) (void)xb_add(&bar[XB_XCNT(b.x)], 1u);
    return b;
}
__device__ __forceinline__ void xcd_barrier_complete(unsigned* bar, unsigned x, unsigned& nloc, unsigned& nx) {
    const unsigned G = gridDim.x * gridDim.y * gridDim.z;
    unsigned sum, cnt, mine, sp = 0u;
    for (;;) {
        sum = 0u; cnt = 0u; mine = 0u;
#pragma unroll
        for (unsigned j = 0; j < 16; ++j) { const unsigned c = xb_ld(&bar[XB_XCNT(j)]); sum += c; cnt += (c > 0u) ? 1u : 0u; mine = (j == x) ? c : mine; }
        if (sum == G) break;
        __builtin_amdgcn_s_sleep(1);
        if ((++sp & 255u) == 0u) { if (xb_ld(&bar[XB_TMO])) break; if (sp > XB_SPIN_CAP) { atomicAdd(&bar[XB_TMO], 1u); break; } }
    }
    nloc = mine > 0u ? mine : 1u; nx = cnt > 0u ? cnt : 1u;
}
__device__ __forceinline__ void xcd_barrier(const XcdBarrier& b) {
    asm volatile("s_waitcnt vmcnt(0)" ::: "memory");
    __syncthreads();
    if (threadIdx.x == 0) {
        unsigned* bar = b.bar;
        __builtin_amdgcn_s_waitcnt(0);
        unsigned nloc = b.st[0], nx = b.st[1];
        if (nloc == 0u) { xcd_barrier_complete(bar, b.x, nloc, nx); b.st[0] = nloc; b.st[1] = nx; }
        const unsigned old = xb_add(&bar[XB_XSUB(b.x)], 1u);
        const unsigned gen = old / nloc;
        if (old + 1u == (gen + 1u) * nloc) {
            __builtin_amdgcn_fence(__ATOMIC_RELEASE, "agent");
            asm volatile("s_waitcnt vmcnt(0)" ::: "memory");
            const unsigned og = xb_add(&bar[XB_TOP], 1u);
            const unsigned tg = og / nx;
            if (og + 1u == (tg + 1u) * nx) xb_add(&bar[XB_TOPGEN], 1u);
            else XB_SPIN(xb_ld(&bar[XB_TOPGEN]) == tg, bar);
            __builtin_amdgcn_fence(__ATOMIC_ACQUIRE, "agent");
            xb_add(&bar[XB_XGEN(b.x)], 1u);
            asm volatile("s_waitcnt vmcnt(0)" ::: "memory");
        } else {
            XB_SPIN(xb_ld(&bar[XB_XGEN(b.x)]) == gen, bar);
            __builtin_amdgcn_fence(__ATOMIC_ACQUIRE, "agent");
            asm volatile("s_waitcnt vmcnt(0)" ::: "memory");
        }
    }
    __syncthreads();
}

extern __shared__ __attribute__((aligned(16))) unsigned char smem_raw[];

__global__ void __launch_bounds__(512) fwd_megakernel(Params p) {
    LAS unsigned char* lds = (LAS unsigned char*)smem_raw;
    Cx c; c.G = gridDim.x; c.ch = 0; c.l = 0;
    const int ph_lo = p.ph_lo, ph_hi = p.ph_hi;
    volatile LAS unsigned* bst = (volatile LAS unsigned*)(lds + pg8::STAGE_BYTES);
    unsigned* bar = (unsigned*)(p.ws + OFF_BAR);
    if (threadIdx.x < 2) bst[threadIdx.x] = 0u;
    if (ph_hi - ph_lo > 1 && blockIdx.x == 0) for (int i = threadIdx.x; i < XCD_BAR_WORDS; i += 512) bar[i] = 0u;
    for (int ph = ph_lo; ph < ph_hi; ++ph) {
        {
            KParams kp = (KParams)__builtin_amdgcn_kernarg_segment_ptr(); asm volatile("" : "+s"(kp)); c.p = kp;
            int t_ = threadIdx.x; asm volatile("" : "+v"(t_)); c.tid = t_;
            int b_ = blockIdx.x; asm volatile("" : "+s"(b_)); c.bid = b_; c.vcu = vcu_of(b_, c.G);
        }
        if (ph == 0) prep_phase(lds, c);
        else {
            const int q = ph - 1; c.ch = q / 13; const int s = q - c.ch * 13; c.l = s / 6; const int k = (s == 12) ? 6 : s - c.l * 6; if (s == 12) c.l = 1;
            if (k == 0) modnorm_phase(c);
            else if (k == 1) { const pg8::Gemm g{1024, 1024, 1024}; pg8::gemm_phase(lds, g, SchedP2(c), EpiP2{c}, c.tid); }
            else if (k == 2) { { const pg8::Gemm g{384, 384, 384}; pg8::gemm_phase(lds, g, SchedP3(c, 0), EpiP3{c, 0}, c.tid); }
                               { const pg8::Gemm g{256, 256, 256}; pg8::gemm_phase(lds, g, SchedP3(c, 1), EpiP3{c, 1}, c.tid); } }
            else if (k == 3) attn_phase(lds, c);
            else if (k == 4) { const pg8::Gemm g{1536, 512, 512}; pg8::gemm_phase(lds, g, SchedP5(c), EpiP5{c}, c.tid); }
            else if (k == 5) { const pg8::Gemm g{1024, 1024, 1024}; pg8::gemm_phase(lds, g, SchedP6(c), EpiP6{c}, c.tid); }
            else finalnorm_phase(c);
        }
        if (ph + 1 < ph_hi) {
            unsigned* barp = (unsigned*)(c.p->ws + OFF_BAR);
            if (ph == ph_lo) { cg::this_grid().sync(); (void)xcd_barrier_post(barp, bst); }
            else { XcdBarrier xb; xb.bar = barp; xb.x = xb_xcc_id(); xb.st = bst; xcd_barrier(xb); }
        }
    }
}

constexpr int LDS_BYTES = pg8::STAGE_BYTES + 256;

extern "C" void kernel_launch(void* const* d_in, const int* in_sizes, int n_in, void* d_out, int out_size, void* d_ws, size_t ws_size, hipStream_t stream) {
    static int grid = 0;
    if (grid == 0) {
        if (n_in != 20 || ws_size < WS_END) { fprintf(stderr, "kernel_launch: unexpected inputs (n_in %d, ws %zu < %zu)\n", n_in, ws_size, (size_t)WS_END); grid = -1; return; }
        int dev = 0, cus = 0, per_cu = 0;
        (void)hipGetDevice(&dev); (void)hipDeviceGetAttribute(&cus, hipDeviceAttributeMultiprocessorCount, dev);
        if (hipFuncSetAttribute((const void*)fwd_megakernel, hipFuncAttributeMaxDynamicSharedMemorySize, LDS_BYTES) != hipSuccess) { fprintf(stderr, "kernel_launch: hipFuncSetAttribute failed\n"); grid = -1; return; }
        if (hipOccupancyMaxActiveBlocksPerMultiprocessor(&per_cu, (const void*)fwd_megakernel, 512, LDS_BYTES) != hipSuccess || per_cu < 1) { fprintf(stderr, "kernel_launch: occupancy query says %d\n", per_cu); per_cu = 1; }
        (void)hipGetLastError();
        grid = cus * 1;
        if (grid <= 0) grid = 256;
    }
    if (grid < 0) return;
    Params p{};
    const float** dst = (const float**)&p;
    for (int i = 0; i < 20; ++i) dst[i] = (const float*)d_in[i];
    p.out = (float*)d_out; p.ws = (unsigned char*)d_ws;
#if MULTI_LAUNCH
    for (int ph = 0; ph < NPHASE; ++ph) { p.ph_lo = ph; p.ph_hi = ph + 1; hipLaunchKernelGGL(fwd_megakernel, dim3(grid), dim3(512), LDS_BYTES, stream, p); }
#else
    p.ph_lo = 0; p.ph_hi = NPHASE;
    void* args[] = {&p};
    hipError_t e = hipLaunchCooperativeKernel((const void*)fwd_megakernel, dim3(grid), dim3(512), args, LDS_BYTES, stream);
    if (e != hipSuccess) fprintf(stderr, "cooperative launch failed: %s (grid %d)\n", hipGetErrorString(e), grid);
#endif
}
```
